# Optimizing an MI355X kernel written in HIP

```python
import jax, jax.numpy as jnp
from jax import lax
import numpy as np

D_MODEL = 1024
BATCH = 2
SEQ = 8192
DEPTH = 1

N_META = 16
HEAD_DIM = 64
RMS_EPS = 1e-6
NEG_INF = -1e30
A_HEADS = 8
A_KV_HEADS = 2
A_WIDTH = A_HEADS * HEAD_DIM
A_KV_WIDTH = A_KV_HEADS * HEAD_DIM
WINDOW = 128
BLOCK = 128
ROT_DIM = HEAD_DIM // 4
ROPE_THETA = 500000.0
B_HEADS = 8
B_WIDTH = B_HEADS * HEAD_DIM
GRID_W = 64
NA_KH_MAX = 8
NA_KW = 16
SPLIT_SIZES = (A_WIDTH, A_KV_WIDTH, A_KV_WIDTH, A_WIDTH,
               B_WIDTH, B_WIDTH, B_WIDTH, B_WIDTH,
               D_MODEL, D_MODEL)
IN_COLS = sum(SPLIT_SIZES)

kernel_name = "hybrid_window_gqa_natten_gated_encoder"


def _rmsnorm(x, gain):
    x32 = x.astype(jnp.float32)
    y = x32 * lax.rsqrt(jnp.mean(x32 * x32, axis=-1, keepdims=True) + RMS_EPS)
    return y.astype(x.dtype) * gain


def _partial_rope(x, pos):
    half = ROT_DIM // 2
    inv_freq = ROPE_THETA ** (-jnp.arange(half, dtype=jnp.float32) / half)
    ang = pos[:, None] * inv_freq[None, :]
    cos = jnp.cos(ang)[None, :, None, :].astype(x.dtype)
    sin = jnp.sin(ang)[None, :, None, :].astype(x.dtype)
    x1 = x[..., :half]
    x2 = x[..., half:ROT_DIM]
    return jnp.concatenate([x1 * cos - x2 * sin, x2 * cos + x1 * sin, x[..., ROT_DIM:]], axis=-1)


def _softmax_with_sink(s, sink):
    s = jnp.concatenate([s, jnp.broadcast_to(sink, s.shape[:-1] + (1,))], axis=-1)
    return jax.nn.softmax(s, axis=-1)[..., :-1]


def _window_gqa(q, k, v, sink):
    bsz, L, _, dh = q.shape
    S = L - N_META
    nb = S // BLOCK
    G = A_HEADS // A_KV_HEADS
    scale = dh ** -0.5
    q = q.reshape(bsz, L, A_KV_HEADS, G, dh)
    qm, qr = q[:, :N_META], q[:, N_META:]
    km, kr = k[:, :N_META], k[:, N_META:]
    vm, vr = v[:, :N_META], v[:, N_META:]
    sink_f = sink.astype(jnp.float32).reshape(A_KV_HEADS, G)

    qb = qr.reshape(bsz, nb, BLOCK, A_KV_HEADS, G, dh)

    def band(t):
        tp = jnp.pad(t, ((0, 0), (BLOCK, BLOCK), (0, 0), (0, 0)))
        tp = tp.reshape(bsz, nb + 2, BLOCK, A_KV_HEADS, dh)
        return jnp.concatenate([tp[:, :-2], tp[:, 1:-1], tp[:, 2:]], axis=2)

    kband, vband = band(kr), band(vr)
    s_band = jnp.einsum('bnqkgd,bnjkd->bkgnqj', qb, kband).astype(jnp.float32) * scale
    qi = jnp.arange(BLOCK)[:, None]
    kj = jnp.arange(3 * BLOCK)[None, :]
    tk = (jnp.arange(nb)[:, None, None] - 1) * BLOCK + kj[None]
    band_mask = (jnp.abs(kj - BLOCK - qi)[None] <= WINDOW) & (tk >= 0) & (tk < S)
    s_band = jnp.where(band_mask, s_band, NEG_INF)
    s_meta = jnp.einsum('bnqkgd,bmkd->bkgnqm', qb, km).astype(jnp.float32) * scale
    p = _softmax_with_sink(jnp.concatenate([s_meta, s_band], axis=-1),
                           sink_f[None, :, :, None, None, None]).astype(v.dtype)
    o_r = (jnp.einsum('bkgnqm,bmkd->bnqkgd', p[..., :N_META], vm)
           + jnp.einsum('bkgnqj,bnjkd->bnqkgd', p[..., N_META:], vband))
    o_r = o_r.reshape(bsz, S, A_HEADS, dh)

    kmq = jnp.concatenate([km, kr[:, :BLOCK]], axis=1)
    vmq = jnp.concatenate([vm, vr[:, :BLOCK]], axis=1)
    s_mq = jnp.einsum('bqkgd,bjkd->bkgqj', qm, kmq).astype(jnp.float32) * scale
    kpos = jnp.arange(N_META + BLOCK)[None, :]
    qpos = jnp.arange(N_META)[:, None]
    s_mq = jnp.where(jnp.abs(kpos - qpos) <= WINDOW, s_mq, NEG_INF)
    p_mq = _softmax_with_sink(s_mq, sink_f[None, :, :, None, None]).astype(v.dtype)
    o_m = jnp.einsum('bkgqj,bjkd->bqkgd', p_mq, vmq).reshape(bsz, N_META, A_HEADS, dh)
    return jnp.concatenate([o_m, o_r], axis=1)


def _neighbourhood_attn(q, k, v, rpb):
    bsz, L, _, dh = q.shape
    S = L - N_META
    rows = S // GRID_W
    kh = min(NA_KH_MAX, rows)
    scale = dh ** -0.5
    qm, km, vm = q[:, :N_META], k[:, :N_META], v[:, :N_META]
    qg = q[:, N_META:].reshape(bsz, rows, GRID_W, B_HEADS, dh)
    kg = k[:, N_META:].reshape(bsz, rows, GRID_W, B_HEADS, dh)
    vg = v[:, N_META:].reshape(bsz, rows, GRID_W, B_HEADS, dh)

    col = jnp.arange(GRID_W)
    col_start = jnp.clip(col - NA_KW // 2, 0, GRID_W - NA_KW)
    col_idx = col_start[:, None] + jnp.arange(NA_KW)[None, :]
    dc_idx = col_idx - col[:, None] + (NA_KW - 1)

    def row_fn(r):
        r_start = jnp.clip(r - kh // 2, 0, rows - kh)
        q_r = lax.dynamic_index_in_dim(qg, r, axis=1, keepdims=False)
        k_rows = lax.dynamic_slice_in_dim(kg, r_start, kh, axis=1)
        v_rows = lax.dynamic_slice_in_dim(vg, r_start, kh, axis=1)
        k_win = k_rows[:, :, col_idx]
        v_win = v_rows[:, :, col_idx]
        s_loc = jnp.einsum('bqhd,brqwhd->bhqrw', q_r, k_win).astype(jnp.float32) * scale
        dr_idx = r_start + jnp.arange(kh) - r + (NA_KH_MAX - 1)
        bias = rpb[:, dr_idx[None, :, None], dc_idx[:, None, :]]
        s_loc = (s_loc + bias[None].astype(jnp.float32)).reshape(bsz, B_HEADS, GRID_W, kh * NA_KW)
        s_met = jnp.einsum('bqhd,bmhd->bhqm', q_r, km).astype(jnp.float32) * scale
        p = jax.nn.softmax(jnp.concatenate([s_met, s_loc], axis=-1), axis=-1).astype(v.dtype)
        p_loc = p[..., N_META:].reshape(bsz, B_HEADS, GRID_W, kh, NA_KW)
        return (jnp.einsum('bhqm,bmhd->bqhd', p[..., :N_META], vm)
                + jnp.einsum('bhqrw,brqwhd->bqhd', p_loc, v_win))

    o_g = lax.map(row_fn, jnp.arange(rows))
    o_r = jnp.transpose(o_g, (1, 0, 2, 3, 4)).reshape(bsz, S, B_HEADS, dh)
    s_mm = jnp.einsum('bqhd,bmhd->bhqm', qm, km).astype(jnp.float32) * scale
    p_mm = jax.nn.softmax(s_mm, axis=-1).astype(v.dtype)
    o_m = jnp.einsum('bhqm,bmhd->bqhd', p_mm, vm)
    return jnp.concatenate([o_m, o_r], axis=1)


def setup_inputs(seed: int = 0) -> dict:
    key = jax.random.key(seed)
    ks = jax.random.split(key, 10)
    f32 = jnp.float32
    x = jax.random.normal(ks[0], (BATCH, SEQ, D_MODEL), f32)
    meta_tokens = jax.random.normal(ks[1], (N_META, D_MODEL), f32)
    norm_gain = 1.0 + 0.01 * jax.random.normal(ks[2], (DEPTH, D_MODEL), f32)
    w_in = jax.random.normal(ks[3], (DEPTH, D_MODEL, IN_COLS), f32) * D_MODEL ** -0.5
    sink_logits = 0.5 * jax.random.normal(ks[4], (DEPTH, A_HEADS), f32)
    rel_pos_bias = 0.02 * jax.random.normal(ks[5], (DEPTH, B_HEADS, 2 * NA_KH_MAX - 1, 2 * NA_KW - 1), f32)
    w_proj_a = jax.random.normal(ks[6], (DEPTH, A_WIDTH, D_MODEL), f32) * A_WIDTH ** -0.5
    w_proj_b = jax.random.normal(ks[7], (DEPTH, B_WIDTH, D_MODEL), f32) * B_WIDTH ** -0.5
    w_out = jax.random.normal(ks[8], (DEPTH, D_MODEL, D_MODEL), f32) * D_MODEL ** -0.5
    final_norm_gain = 1.0 + 0.01 * jax.random.normal(ks[9], (D_MODEL,), f32)
    return {"x": x, "meta_tokens": meta_tokens, "norm_gain": norm_gain, "w_in": w_in,
            "sink_logits": sink_logits, "rel_pos_bias": rel_pos_bias, "w_proj_a": w_proj_a,
            "w_proj_b": w_proj_b, "w_out": w_out, "final_norm_gain": final_norm_gain}


def reference(x, meta_tokens, norm_gain, w_in, sink_logits, rel_pos_bias, w_proj_a, w_proj_b,
              w_out, final_norm_gain):
    bsz, S, _ = x.shape
    L = S + N_META
    h = jnp.concatenate([jnp.broadcast_to(meta_tokens[None].astype(x.dtype), (bsz, N_META, D_MODEL)), x], axis=1)
    pos = jnp.arange(L, dtype=jnp.float32)
    split_points = list(np.cumsum(SPLIT_SIZES)[:-1])
    for l in range(DEPTH):
        n = _rmsnorm(h, norm_gain[l])
        proj = jnp.einsum('bld,dc->blc', n, w_in[l])
        qa, ka, va, za, qb, kb, vb, zb, ga, gb = jnp.split(proj, split_points, axis=-1)
        qa = _partial_rope(qa.reshape(bsz, L, A_HEADS, HEAD_DIM), pos)
        ka = _partial_rope(ka.reshape(bsz, L, A_KV_HEADS, HEAD_DIM), pos)
        va = va.reshape(bsz, L, A_KV_HEADS, HEAD_DIM)
        oa = _window_gqa(qa, ka, va, sink_logits[l]).reshape(bsz, L, A_WIDTH) * jax.nn.silu(za)
        ob = _neighbourhood_attn(qb.reshape(bsz, L, B_HEADS, HEAD_DIM),
                                 kb.reshape(bsz, L, B_HEADS, HEAD_DIM),
                                 vb.reshape(bsz, L, B_HEADS, HEAD_DIM),
                                 rel_pos_bias[l]).reshape(bsz, L, B_WIDTH) * jax.nn.silu(zb)
        merged = (jax.nn.sigmoid(ga) * jnp.einsum('blc,cd->bld', oa, w_proj_a[l])
                  + jax.nn.sigmoid(gb) * jnp.einsum('blc,cd->bld', ob, w_proj_b[l]))
        h = h + jnp.einsum('bld,de->ble', merged, w_out[l])
    return _rmsnorm(h, final_norm_gain)[:, N_META:]
```

```cpp
#include <hip/hip_runtime.h>
#include <hip/hip_cooperative_groups.h>
#include <cstdio>
#include <cstdint>
namespace cg = cooperative_groups;
namespace pg8 {
#define PG8_LAS __attribute__((address_space(3)))
typedef unsigned short bf16_t;
typedef short bf16x8 __attribute__((ext_vector_type(8)));
typedef float f32x4 __attribute__((ext_vector_type(4)));
typedef unsigned u32x4 __attribute__((ext_vector_type(4)));
constexpr int BM = 256, BK = 64, HALF = 128, HTB = HALF * BK * 2  , STAGE_BYTES = 8 * HTB, NXCD = 8, WGM = 8;

__host__ __device__ __forceinline__ int lds_byte(int r, int c) { const int st = (r >> 4) * 2 + (c >> 5), rr = r & 15, cc = c & 31, ob = rr * 64 + cc * 2; return st * 1024 + (ob ^ (((ob >> 9) & 1) << 5)); }
__host__ __device__ __forceinline__ void stage_rc(int b, int& R, int& C) { const int st = b / 1024, sb = b % 1024, swz = sb ^ (((sb >> 9) & 1) << 5); R = (st >> 1) * 16 + swz / 64; C = (st & 1) * 32 + (swz % 64) / 2; }
__host__ __device__ __forceinline__ int perm32(int rho) { const int n = rho >> 4, i = rho & 15; return 8 * (i >> 2) + 4 * n + (i & 3); }

struct Unit { int pm, pn; };
struct Gemm { const bf16_t* A; const bf16_t* Bt; int M, N, K; };

struct StaticOrder {
    int nM, nN, nwg, G, c;
    __host__ __device__ void init(int M, int N, int G_, int c_) { nM = M / BM; nN = N / BM; nwg = nM * nN; G = G_; c = c_; }
    __host__ __device__ bool next(int i, Unit& u) const {
        const long L = (long)i * G + c; if (L >= nwg) return false;
        int wgid = (int)L; { const int q = nwg / NXCD, r = nwg % NXCD, xcd = wgid % NXCD, off = wgid / NXCD; wgid = (xcd < r ? xcd * (q + 1) : r * (q + 1) + (xcd - r) * q) + off; }
        const int nig = WGM * nN, gid = wgid / nig, fm = gid * WGM, gsz = (nM - fm) < WGM ? (nM - fm) : WGM;
        u.pm = fm + ((wgid % nig) % gsz); u.pn = (wgid % nig) / gsz; return true;
    }
    __device__ __forceinline__ void a_ready(const Unit&) const {}
    __device__ __forceinline__ void done(const Unit&) const {}
};
__device__ __forceinline__ unsigned cvt_pk_bf16(float lo, float hi) { unsigned r; asm volatile("v_cvt_pk_bf16_f32 %0, %1, %2" : "=v"(r) : "v"(lo), "v"(hi)); return r; }
constexpr int PROJ_LD = 5376;
constexpr float QSCALE = 0.18033688011112042f;
__device__ __forceinline__ float bfl(unsigned u) { return __builtin_bit_cast(float, u << 16); }
__device__ __forceinline__ float bfh(unsigned u) { return __builtin_bit_cast(float, u & 0xffff0000u); }
__device__ __forceinline__ float sigmoidf_(float x) { return 1.f / (1.f + __expf(-x)); }

struct EpiProj {
    static constexpr bool PERM = true, AFTER_DRAIN = false;
    bf16_t* O; const float* rope;
    __device__ __forceinline__ void operator()(const f32x4 (&acc)[2][2][4][2], const Unit& u, int wr, int wc, int fr, int fq) const {
        const int pn = u.pn;
        const bool rope_t = (pn <= 2) && ((wc & 1) == 0);
        const float sc = (pn <= 1 || pn == 5 || pn == 6) ? QSCALE : 1.f;
        const int row0 = u.pm * BM + wr * 64 + fr, col0 = pn * BM + wc * 32 + 8 * fq;
#pragma unroll
        for (int ai = 0; ai < 2; ++ai)
#pragma unroll
            for (int m = 0; m < 4; ++m) {
                const int row = row0 + ai * HALF + m * 16;
                f32x4 c0 = {1.f, 1.f, 1.f, 1.f}, c1 = c0, s0 = {0.f, 0.f, 0.f, 0.f}, s1 = s0;
                if (rope_t) { const int pos = row < 16384 ? (row & 8191) + 16 : row - 16384; const f32x4* rp = (const f32x4*)(rope + (size_t)pos * 16);
                    c0 = rp[0]; c1 = rp[1]; s0 = rp[2]; s1 = rp[3]; }
                bf16_t* rowp = O + (size_t)row * PROJ_LD + col0;
#pragma unroll
                for (int bj = 0; bj < 2; ++bj) {
                    f32x4 v0 = acc[ai][bj][m][0], v1 = acc[ai][bj][m][1];
                    if (rope_t && (pn < 2 || bj == 0)) {
                        f32x4 p0, p1;
#pragma unroll
                        for (int i = 0; i < 4; ++i) { p0[i] = __shfl_xor(v0[i], 16); p1[i] = __shfl_xor(v1[i], 16); }
                        if (fq == 0) { v0 = v0 * c0 - p0 * s0; v1 = v1 * c1 - p1 * s1; }
                        else if (fq == 1) { v0 = v0 * c0 + p0 * s0; v1 = v1 * c1 + p1 * s1; }
                    }
                    v0 = v0 * sc; v1 = v1 * sc;
                    u32x4 w; w.x = cvt_pk_bf16(v0[0], v0[1]); w.y = cvt_pk_bf16(v0[2], v0[3]); w.z = cvt_pk_bf16(v1[0], v1[1]); w.w = cvt_pk_bf16(v1[2], v1[3]);
                    *(u32x4*)(rowp + bj * HALF) = w;
                }
            }
    }
};

struct EpiMerge {
    static constexpr bool PERM = true, AFTER_DRAIN = false;
    const bf16_t* proj; bf16_t* merged;
    __device__ __forceinline__ void operator()(const f32x4 (&acc)[2][2][4][2], const Unit& u, int wr, int wc, int fr, int fq) const {
        const int part = u.pn >= 4 ? 1 : 0, pm = u.pm - 64 * part, pn = u.pn - 4 * part;
        const int row0 = pm * BM + wr * 64 + fr, col0 = pn * BM + wc * 32 + 8 * fq;
        const int gcol = (part ? 4352 : 3328) + col0;
#pragma unroll
        for (int ai = 0; ai < 2; ++ai)
#pragma unroll
            for (int m = 0; m < 4; ++m) {
                const int row = row0 + ai * HALF + m * 16;
#pragma unroll
                for (int bj = 0; bj < 2; ++bj) {
                    const u32x4 g = *(const u32x4*)(proj + (size_t)row * PROJ_LD + gcol + bj * HALF);
                    bf16_t* mp = merged + (size_t)row * 1024 + col0 + bj * HALF;
                    const f32x4 a0 = acc[ai][bj][m][0], a1 = acc[ai][bj][m][1];
                    float v[8];
                    v[0] = sigmoidf_(bfl(g.x)) * a0[0]; v[1] = sigmoidf_(bfh(g.x)) * a0[1]; v[2] = sigmoidf_(bfl(g.y)) * a0[2]; v[3] = sigmoidf_(bfh(g.y)) * a0[3];
                    v[4] = sigmoidf_(bfl(g.z)) * a1[0]; v[5] = sigmoidf_(bfh(g.z)) * a1[1]; v[6] = sigmoidf_(bfl(g.w)) * a1[2]; v[7] = sigmoidf_(bfh(g.w)) * a1[3];
                    if (part) { const u32x4 p = *(const u32x4*)mp;
                        v[0] += bfl(p.x); v[1] += bfh(p.x); v[2] += bfl(p.y); v[3] += bfh(p.y); v[4] += bfl(p.z); v[5] += bfh(p.z); v[6] += bfl(p.w); v[7] += bfh(p.w); }
                    u32x4 w; w.x = cvt_pk_bf16(v[0], v[1]); w.y = cvt_pk_bf16(v[2], v[3]); w.z = cvt_pk_bf16(v[4], v[5]); w.w = cvt_pk_bf16(v[6], v[7]);
                    *(u32x4*)mp = w;
                }
            }
    }
};

struct EpiOut {
    static constexpr bool PERM = true, AFTER_DRAIN = false;
    const float* x; float* out; float* ssq;
    __device__ __forceinline__ void operator()(const f32x4 (&acc)[2][2][4][2], const Unit& u, int wr, int wc, int fr, int fq) const {
        const int row0 = u.pm * BM + wr * 64 + fr, col0 = u.pn * BM + wc * 32 + 8 * fq;
#pragma unroll
        for (int ai = 0; ai < 2; ++ai)
#pragma unroll
            for (int m = 0; m < 4; ++m) {
                const int row = row0 + ai * HALF + m * 16; float s = 0.f;
#pragma unroll
                for (int bj = 0; bj < 2; ++bj) {
                    const size_t o = (size_t)row * 1024 + col0 + bj * HALF;
                    const f32x4 h0 = *(const f32x4*)(x + o) + acc[ai][bj][m][0], h1 = *(const f32x4*)(x + o + 4) + acc[ai][bj][m][1];
                    *(f32x4*)(out + o) = h0; *(f32x4*)(out + o + 4) = h1;
                    s += (h0[0] * h0[0] + h0[1] * h0[1]) + (h0[2] * h0[2] + h0[3] * h0[3]) + (h1[0] * h1[0] + h1[1] * h1[1]) + (h1[2] * h1[2] + h1[3] * h1[3]);
                }
                s += __shfl_xor(s, 16); s += __shfl_xor(s, 32);
                if (fq == 0) ssq[(size_t)row * 16 + u.pn * 4 + wc] = s;
            }
    }
};

struct ProjOrder {
    StaticOrder so; int G, c;
    __device__ void init(int G_, int c_) { so.init(16384, 5376, G_, c_); G = G_; c = c_; }
    __device__ bool next(int i, Unit& u) const {
        const long L = (long)i * G + c;
        if (L < 1344) return so.next(i, u);
        const int e = (int)(L - 1344); if (e >= 5) return false;
        u.pm = 64; u.pn = e == 0 ? 2 : 6 + e; return true;
    }
    __device__ __forceinline__ void a_ready(const Unit&) const {}
    __device__ __forceinline__ void done(const Unit&) const {}
};
struct MergeOrder {
    int G, c;
    __device__ bool next(int i, Unit& u) const {
        const int T = c + (i >> 1) * G; if (T >= 256) return false;
        const int part = i & 1, x = T & 7, o = T >> 3;
        u.pm = 8 * x + (o & 7) + 64 * part; u.pn = (o >> 3) + 4 * part; return true;
    }
    __device__ __forceinline__ void a_ready(const Unit&) const {}
    __device__ __forceinline__ void done(const Unit&) const {}
};
template <class Epi, class Sched, bool ALIGN_EPI = false, bool SP2 = false>
__device__ __forceinline__ void gemm_phase(PG8_LAS unsigned char* lds, const Gemm g, const Sched& S, const Epi& E) {
    const int tid = threadIdx.x, wid = __builtin_amdgcn_readfirstlane(tid >> 6), lane = tid & 63, wr = wid >> 2, wc = wid & 3, fr = lane & 15, fq = lane >> 4;
    const int K = g.K, nt = K / BK;
    unsigned voffA[2], voffB[2];
#pragma unroll
    for (int i = 0; i < 2; ++i) { int R, C; stage_rc(tid * 16 + i * 8192, R, C); const int Rb = Epi::PERM ? ((R & ~31) + perm32(R & 31)) : R;
        voffA[i] = (unsigned)(R * K + C) * 2u; voffB[i] = (unsigned)(Rb * K + C) * 2u; }
    const size_t kstep = (size_t)(BK * 2);
    const size_t hstep = (size_t)HALF * K * 2;
    const size_t tstep = 2 * hstep;
    const unsigned ldsw = (unsigned)wid * 1024u;
    const int aoff = lds_byte(wr * 64 + fr, fq * 8), boff = lds_byte(wc * 32 + fr, fq * 8);
#define PG8_SA(b, h) (((b) * 2 + (h)) * HTB)
#define PG8_SB(b, h) ((4 + (b) * 2 + (h)) * HTB)
#define PG8_STAGE(bufoff, gbase, voff) do { _Pragma("unroll") for (int _i = 0; _i < 2; ++_i) \
        __builtin_amdgcn_global_load_lds((const unsigned*)((const char*)(gbase) + (voff)[_i]), (PG8_LAS unsigned*)(lds + (bufoff) + ldsw + _i * 8192), 16, 0, 0); } while (0)
#define PG8_LDA(dst, b, h) do { _Pragma("unroll") for (int m = 0; m < 4; ++m) _Pragma("unroll") for (int k = 0; k < 2; ++k) dst[m][k] = *(const PG8_LAS bf16x8*)(lds + PG8_SA(b, h) + aoff + m * 2048 + k * 1024); } while (0)
#define PG8_LDB(dst, b, h) do { _Pragma("unroll") for (int n = 0; n < 2; ++n) _Pragma("unroll") for (int k = 0; k < 2; ++k) dst[n][k] = *(const PG8_LAS bf16x8*)(lds + PG8_SB(b, h) + boff + n * 2048 + k * 1024); } while (0)
#define PG8_MMA(ai, bj, At, Bt) do { __builtin_amdgcn_s_setprio(1); _Pragma("unroll") for (int m = 0; m < 4; ++m) _Pragma("unroll") for (int n = 0; n < 2; ++n) _Pragma("unroll") for (int k = 0; k < 2; ++k) \
        acc[ai][bj][m][n] = __builtin_amdgcn_mfma_f32_16x16x32_bf16(Bt[n][k], At[m][k], acc[ai][bj][m][n], 0, 0, 0); __builtin_amdgcn_s_setprio(0); } while (0)
#define PG8_WAIT_V(n) asm volatile("s_waitcnt vmcnt(" #n ")" ::: "memory")
#define PG8_WAIT_L(n) asm volatile("s_waitcnt lgkmcnt(" #n ")" ::: "memory")
#define PG8_BAR __builtin_amdgcn_s_barrier()
#define PG8_SCHED __builtin_amdgcn_sched_barrier(0)
    Unit cur, nxt; int ui = 0;
    if (!S.next(0, cur)) return;
    f32x4 acc[2][2][4][2];
#pragma unroll
    for (int a = 0; a < 2; ++a)
#pragma unroll
        for (int b = 0; b < 2; ++b)
#pragma unroll
            for (int m = 0; m < 4; ++m)
#pragma unroll
                for (int n = 0; n < 2; ++n) acc[a][b][m][n] = (f32x4){0.f, 0.f, 0.f, 0.f};
    bf16x8 At[4][2], B0[2][2], B1[2][2];
    const char* cA = (const char*)g.A + (size_t)cur.pm * tstep; const char* cB = (const char*)g.Bt + (size_t)cur.pn * tstep;
    S.a_ready(cur);
    if constexpr (SP2) {
        PG8_STAGE(PG8_SB(0, 0), cB, voffB); PG8_STAGE(PG8_SB(0, 1), cB + hstep, voffB); PG8_STAGE(PG8_SA(0, 0), cA, voffA); PG8_STAGE(PG8_SA(0, 1), cA + hstep, voffA);
        if (wr == 1) PG8_BAR;
        PG8_WAIT_V(2); PG8_BAR;
        PG8_STAGE(PG8_SB(1, 0), cB + kstep, voffB); PG8_STAGE(PG8_SA(1, 0), cA + kstep, voffA); PG8_STAGE(PG8_SB(1, 1), cB + hstep + kstep, voffB);
        PG8_WAIT_V(6); PG8_BAR;
    } else {
        PG8_STAGE(PG8_SB(0, 0), cB, voffB); PG8_STAGE(PG8_SA(0, 0), cA, voffA); PG8_STAGE(PG8_SB(0, 1), cB + hstep, voffB); PG8_STAGE(PG8_SA(0, 1), cA + hstep, voffA);
        if (wr == 1) PG8_BAR;
        PG8_WAIT_V(4); PG8_BAR;
        PG8_STAGE(PG8_SB(1, 0), cB + kstep, voffB); PG8_STAGE(PG8_SA(1, 0), cA + kstep, voffA); PG8_STAGE(PG8_SB(1, 1), cB + hstep + kstep, voffB);
        PG8_WAIT_V(6); PG8_BAR;
    }
    for (;;) {
        const bool has_next = S.next(ui + 1, nxt);
        const char* nA = has_next ? (const char*)g.A + (size_t)nxt.pm * tstep : cA; const char* nB = has_next ? (const char*)g.Bt + (size_t)nxt.pn * tstep : cB;
        for (int t = 0; t < nt; t += 2) {
            const bool last = (t == nt - 2);
            const char* a1 = cA + (size_t)(t + 1) * kstep;
            const char* a2 = last ? nA : cA + (size_t)(t + 2) * kstep; const char* b2 = last ? nB : cB + (size_t)(t + 2) * kstep;
            const char* a3 = a2 + kstep; const char* b3 = b2 + kstep;
            if (last && has_next) S.a_ready(nxt);
            if constexpr (SP2) {
            PG8_LDB(B0, 0, 0); PG8_LDB(B1, 0, 1); PG8_SCHED; PG8_LDA(At, 0, 0); PG8_STAGE(PG8_SA(1, 1), a1 + hstep, voffA);
            PG8_WAIT_V(8); PG8_WAIT_L(0); PG8_BAR; PG8_MMA(0, 0, At, B0); PG8_MMA(0, 1, At, B1); PG8_BAR; PG8_SCHED;
            PG8_LDA(At, 0, 1); PG8_STAGE(PG8_SB(0, 0), b2, voffB); PG8_STAGE(PG8_SB(0, 1), b2 + hstep, voffB); PG8_STAGE(PG8_SA(0, 0), a2, voffA);
            PG8_WAIT_V(8); PG8_WAIT_L(0); PG8_BAR; PG8_MMA(1, 0, At, B0); PG8_MMA(1, 1, At, B1); PG8_BAR; PG8_SCHED;
            PG8_LDB(B0, 1, 0); PG8_LDB(B1, 1, 1); PG8_SCHED; PG8_LDA(At, 1, 0); PG8_STAGE(PG8_SA(0, 1), a2 + hstep, voffA);
            PG8_WAIT_V(8); PG8_WAIT_L(0); PG8_BAR; PG8_MMA(0, 0, At, B0); PG8_MMA(0, 1, At, B1); PG8_BAR; PG8_SCHED;
            PG8_LDA(At, 1, 1); PG8_STAGE(PG8_SB(1, 0), b3, voffB); PG8_STAGE(PG8_SB(1, 1), b3 + hstep, voffB); PG8_STAGE(PG8_SA(1, 0), a3, voffA);
            PG8_WAIT_V(8); PG8_WAIT_L(0); PG8_BAR; PG8_MMA(1, 0, At, B0); PG8_MMA(1, 1, At, B1); PG8_BAR; PG8_SCHED;
            } else {
            PG8_LDB(B0, 0, 0); PG8_SCHED; PG8_LDA(At, 0, 0); PG8_STAGE(PG8_SA(1, 1), a1 + hstep, voffA);
            PG8_WAIT_L(8); PG8_BAR; PG8_WAIT_L(0); PG8_MMA(0, 0, At, B0); PG8_BAR; PG8_SCHED;
            PG8_LDB(B1, 0, 1); PG8_STAGE(PG8_SB(0, 0), b2, voffB);
            PG8_BAR; PG8_WAIT_L(0); PG8_MMA(0, 1, At, B1); PG8_BAR;
            PG8_LDA(At, 0, 1); PG8_STAGE(PG8_SA(0, 0), a2, voffA);
            PG8_BAR; PG8_WAIT_L(0); PG8_MMA(1, 0, At, B0); PG8_BAR; PG8_SCHED;
            PG8_STAGE(PG8_SB(0, 1), b2 + hstep, voffB);
            PG8_WAIT_V(6); PG8_BAR; PG8_MMA(1, 1, At, B1); PG8_BAR;
            PG8_LDB(B0, 1, 0); PG8_SCHED; PG8_LDA(At, 1, 0); PG8_STAGE(PG8_SA(0, 1), a2 + hstep, voffA);
            PG8_WAIT_L(8); PG8_BAR; PG8_WAIT_L(0); PG8_MMA(0, 0, At, B0); PG8_BAR; PG8_SCHED;
            PG8_LDB(B1, 1, 1); PG8_STAGE(PG8_SB(1, 0), b3, voffB);
            PG8_BAR; PG8_WAIT_L(0); PG8_MMA(0, 1, At, B1); PG8_BAR;
            PG8_LDA(At, 1, 1); PG8_STAGE(PG8_SA(1, 0), a3, voffA);
            PG8_BAR; PG8_WAIT_L(0); PG8_MMA(1, 0, At, B0); PG8_BAR; PG8_SCHED;
            PG8_STAGE(PG8_SB(1, 1), b3 + hstep, voffB);
            PG8_WAIT_V(6); PG8_BAR; PG8_MMA(1, 1, At, B1); PG8_BAR;
            }
        }
        if constexpr (ALIGN_EPI) { if (wr == 0) PG8_BAR; }
        if constexpr (!Epi::AFTER_DRAIN) { E(acc, cur, wr, wc, fr, fq); S.done(cur); }
        if (!has_next) break;
#pragma unroll
        for (int a = 0; a < 2; ++a)
#pragma unroll
            for (int b = 0; b < 2; ++b)
#pragma unroll
                for (int m = 0; m < 4; ++m)
#pragma unroll
                    for (int n = 0; n < 2; ++n) acc[a][b][m][n] = (f32x4){0.f, 0.f, 0.f, 0.f};
        cur = nxt; cA = nA; cB = nB; ++ui;
        if constexpr (ALIGN_EPI) { if (wr == 1) PG8_BAR; }
    }
    PG8_WAIT_V(0);
    if constexpr (!ALIGN_EPI) { if (wr == 0) PG8_BAR; }
    PG8_BAR;
    if constexpr (Epi::AFTER_DRAIN) { E.fused(acc, cur, wr, wc, fr, fq, lds, wid, lane); S.done(cur); }
#undef PG8_SA
#undef PG8_SB
#undef PG8_STAGE
#undef PG8_LDA
#undef PG8_LDB
#undef PG8_MMA
#undef PG8_WAIT_V
#undef PG8_WAIT_L
#undef PG8_BAR
#undef PG8_SCHED
}
}
#define GAS __attribute__((address_space(1)))
#define LAS __attribute__((address_space(3)))
typedef unsigned short bf16;
typedef unsigned v4u __attribute__((ext_vector_type(4)));
typedef unsigned v2u __attribute__((ext_vector_type(2)));
typedef float f32x4 __attribute__((ext_vector_type(4)));
typedef short bf16x8 __attribute__((ext_vector_type(8)));
constexpr int NWAVES = 8;
constexpr int M = 16384, D = 1024, NC = 5376, MP = 16640, SEQ = 8192, NMETA = 16, LPOS = SEQ + NMETA;
constexpr int C_QA = 0, C_KA = 512, C_VA = 640, C_ZA = 768, C_QB = 1280, C_KB = 1792, C_VB = 2304, C_ZB = 2816, C_GA = 3328, C_GB = 4352;
constexpr float RMS_EPS = 1e-6f, LOG2E = 1.4426950408889634f;
constexpr size_t MiB = 1u << 20;
constexpr size_t WS_WIN = 1 * MiB, WS_WP = 12 * MiB, WS_WO = 14 * MiB, WS_ROPE = 16 * MiB, WS_SSQ = 17 * MiB, WS_XN = 18 * MiB, WS_MG = 51 * MiB, WS_PROJ = 84 * MiB;
static_assert(WS_XN + (size_t)MP * D * 2 <= WS_MG && WS_MG + (size_t)M * D * 2 <= WS_PROJ && WS_PROJ + (size_t)MP * NC * 2 <= 256 * MiB, "ws map");
constexpr int LDS_BYTES = 163840 - 4096;
#define LDS_WAIT() asm volatile("s_waitcnt lgkmcnt(0)" ::: "memory")
__device__ __forceinline__ unsigned f2bf(float f) { unsigned u = __builtin_bit_cast(unsigned, f); return (u + 0x7fffu + ((u >> 16) & 1u)) >> 16; }
__device__ __forceinline__ unsigned pk2(float lo, float hi) { return f2bf(lo) | (f2bf(hi) << 16); }
__device__ __forceinline__ float bf2f(unsigned short h) { return __builtin_bit_cast(float, (unsigned)h << 16); }
__device__ __forceinline__ float wave_sum(float v) {
#pragma unroll
    for (int o = 1; o < 64; o <<= 1) v += __shfl_xor(v, o);
    return v;
}
__device__ __forceinline__ float wave_max(float v) {
#pragma unroll
    for (int o = 1; o < 64; o <<= 1) v = fmaxf(v, __shfl_xor(v, o));
    return v;
}

struct Args { const float* in[10]; float* out; unsigned char* ws; };

__device__ __forceinline__ void p0_transpose_item(const float* W, int K, int N, bf16* WT, int row_off, LAS float* scr, int item, int lane) {
    const int nblk = N / 32, kb = item / nblk, nb = item % nblk, k0 = 64 * kb, n0 = 32 * nb;
#pragma unroll 8
    for (int i = 0; i < 32; ++i) { const int kk = 2 * i + (lane >> 5); scr[kk * 33 + (lane & 31)] = W[(size_t)(k0 + kk) * N + n0 + (lane & 31)]; }
    LDS_WAIT(); asm volatile("" ::: "memory");
    const int c = lane & 7;
#pragma unroll
    for (int j = 0; j < 4; ++j) { const int n = (lane >> 3) + 8 * j; const LAS float* s = scr + (8 * c) * 33 + n;
        v4u o; o.x = pk2(s[0 * 33], s[1 * 33]); o.y = pk2(s[2 * 33], s[3 * 33]); o.z = pk2(s[4 * 33], s[5 * 33]); o.w = pk2(s[6 * 33], s[7 * 33]);
        *(v4u*)(WT + (size_t)(row_off + n0 + n) * K + k0 + 8 * c) = o; }
    LDS_WAIT(); asm volatile("" ::: "memory");
}

__device__ __forceinline__ void p0_prologue(const Args& a, LAS unsigned char* lds, int wave, int lane, int G) {
    unsigned char* ws = a.ws;
    LAS float* scr = (LAS float*)(lds + wave * 16384);
    const int gw = blockIdx.x * NWAVES + wave, NGW = G * NWAVES;
    constexpr int I_IN = (D / 64) * (NC / 32), I_PA = (512 / 64) * (D / 32), I_O = (D / 64) * (D / 32);
    constexpr int NITEMS = I_IN + 2 * I_PA + I_O;
    for (int it = gw; it < NITEMS; it += NGW) {
        int r = it;
        if (r < I_IN) { p0_transpose_item(a.in[3], D, NC, (bf16*)(ws + WS_WIN), 0, scr, r, lane); continue; } r -= I_IN;
        if (r < I_PA) { p0_transpose_item(a.in[6], 512, D, (bf16*)(ws + WS_WP), 0, scr, r, lane); continue; } r -= I_PA;
        if (r < I_PA) { p0_transpose_item(a.in[7], 512, D, (bf16*)(ws + WS_WP), 1024, scr, r, lane); continue; } r -= I_PA;
        p0_transpose_item(a.in[8], D, D, (bf16*)(ws + WS_WO), 0, scr, r, lane);
    }
    bf16* XN = (bf16*)(ws + WS_XN);
    const f32x4* gp = (const f32x4*)a.in[2] + lane;
    for (int m = gw; m < MP; m += NGW) {
        unsigned long long* o8 = (unsigned long long*)(XN + (size_t)m * D) + lane;
        if (m >= M + NMETA) {
#pragma unroll
            for (int j = 0; j < 4; ++j) o8[64 * j] = 0ull;
            continue;
        }
        const float* xrow = m < M ? a.in[0] + (size_t)m * D : a.in[1] + (size_t)(m - M) * D;
        const f32x4* xr = (const f32x4*)xrow + lane;
        f32x4 v[4]; float s = 0.f;
#pragma unroll
        for (int j = 0; j < 4; ++j) { v[j] = xr[64 * j]; s += (v[j].x * v[j].x + v[j].y * v[j].y) + (v[j].z * v[j].z + v[j].w * v[j].w); }
        const float rs = 1.f / sqrtf(wave_sum(s) * (1.f / D) + RMS_EPS);
#pragma unroll
        for (int j = 0; j < 4; ++j) { const f32x4 g = gp[64 * j]; const f32x4 y = v[j] * rs * g;
            o8[64 * j] = (unsigned long long)pk2(y.x, y.y) | ((unsigned long long)pk2(y.z, y.w) << 32); }
    }
    float* rope = (float*)(ws + WS_ROPE);
    const float inv_freq[8] = {1.0f, 0.19392274474868576f, 0.03760603093086393f, 0.007292664737217109f, 0.001414213562373095f, 0.0002742481756762073f, 5.318295896944988e-05f, 1.031338537721246e-05f};
    for (int pos = (int)threadIdx.x * G + (int)blockIdx.x; pos < LPOS; pos += G * 512) {
#pragma unroll
        for (int j = 0; j < 8; ++j) {
            const float ang = (float)pos * inv_freq[j];
            const double x = (double)ang, kq = __builtin_rint(x * 0.15915494309189535), r = x - kq * 6.283185307179586, r2 = r * r;
            double ts = 1.0, tc = 1.0, sn = 1.0, cs = 1.0;
#pragma unroll
            for (int n = 1; n <= 15; ++n) { tc *= r2 * (-1.0 / (double)((2 * n - 1) * (2 * n))); ts *= r2 * (-1.0 / (double)((2 * n) * (2 * n + 1))); cs += tc; sn += ts; }
            sn *= r;
            rope[pos * 16 + j] = (float)cs; rope[pos * 16 + 8 + j] = (float)sn;
        }
    }
}

__device__ __forceinline__ void naive_attn_phase(const Args& a, LAS unsigned char* lds, int wave, int lane, int G) {
    const bf16* PROJ = (const bf16*)(a.ws + WS_PROJ);
    bf16* OAB = (bf16*)(a.ws + WS_XN);
    const float* sink = a.in[4]; const float* rpb = a.in[5];
    LAS float* pbuf = (LAS float*)(lds + wave * 2048);
    const int gw = blockIdx.x * NWAVES + wave, NGW = G * NWAVES;
    for (int it = gw; it < 2 * M * 8; it += NGW) {
        const int which = it >= M * 8 ? 1 : 0, r = it - which * M * 8, tok = r >> 3, h = r & 7, b = tok >> 13, t = tok & 8191;
        int qcol, kcol, vcol, zcol, nloc, t0 = 0, gr = 0, gc = 0, rs = 0, cs = 0;
        if (!which) { const int kvh = h >> 2; qcol = C_QA + h * 64; kcol = C_KA + kvh * 64; vcol = C_VA + kvh * 64; zcol = C_ZA + h * 64;
            t0 = t - 128 < 0 ? 0 : t - 128; const int t1 = t + 128 > SEQ - 1 ? SEQ - 1 : t + 128; nloc = t1 - t0 + 1; }
        else { qcol = C_QB + h * 64; kcol = C_KB + h * 64; vcol = C_VB + h * 64; zcol = C_ZB + h * 64; nloc = 128; gr = t >> 6; gc = t & 63;
            rs = gr - 4 < 0 ? 0 : (gr - 4 > 120 ? 120 : gr - 4); cs = gc - 8 < 0 ? 0 : (gc - 8 > 48 ? 48 : gc - 8); }
        const int nk = 16 + nloc;
        v4u qv[8];
        { const v4u* qp = (const v4u*)(PROJ + (size_t)tok * NC + qcol);
#pragma unroll
          for (int i = 0; i < 8; ++i) qv[i] = qp[i]; }
        float sv[5]; float mx = which ? -1e30f : sink[h] * LOG2E;
#pragma unroll
        for (int jj = 0; jj < 5; ++jj) {
            const int idx = lane + 64 * jj; float s = -1e30f;
            if (idx < nk) {
                int krow; float bias = 0.f;
                if (idx < 16) krow = M + idx;
                else if (!which) krow = b * SEQ + t0 + (idx - 16);
                else { const int j = idx - 16, kr = j >> 4, kc = j & 15; krow = b * SEQ + (rs + kr) * 64 + cs + kc;
                    bias = rpb[(h * 15 + (rs + kr - gr + 7)) * 31 + (cs + kc - gc + 15)] * LOG2E; }
                const v4u* kp = (const v4u*)(PROJ + (size_t)krow * NC + kcol);
                float acc = 0.f;
#pragma unroll
                for (int i = 0; i < 8; ++i) { const v4u kv = kp[i]; const v4u q = qv[i];
                    acc += pg8::bfl(q.x) * pg8::bfl(kv.x) + pg8::bfh(q.x) * pg8::bfh(kv.x) + pg8::bfl(q.y) * pg8::bfl(kv.y) + pg8::bfh(q.y) * pg8::bfh(kv.y)
                         + pg8::bfl(q.z) * pg8::bfl(kv.z) + pg8::bfh(q.z) * pg8::bfh(kv.z) + pg8::bfl(q.w) * pg8::bfl(kv.w) + pg8::bfh(q.w) * pg8::bfh(kv.w); }
                s = acc + bias;
            }
            sv[jj] = s; mx = fmaxf(mx, s);
        }
        mx = wave_max(mx);
        float l = 0.f;
#pragma unroll
        for (int jj = 0; jj < 5; ++jj) { const int idx = lane + 64 * jj; const float p = idx < nk ? exp2f(sv[jj] - mx) : 0.f; sv[jj] = p; l += p; }
        l = wave_sum(l); if (!which) l += exp2f(sink[h] * LOG2E - mx);
        const float inv = 1.f / l;
#pragma unroll
        for (int jj = 0; jj < 5; ++jj) { const int idx = lane + 64 * jj; if (idx < nk) pbuf[idx] = sv[jj] * inv; }
        LDS_WAIT(); asm volatile("" ::: "memory");
        float o = 0.f;
        for (int idx = 0; idx < nk; ++idx) {
            int krow;
            if (idx < 16) krow = M + idx;
            else if (!which) krow = b * SEQ + t0 + (idx - 16);
            else { const int j = idx - 16; krow = b * SEQ + (rs + (j >> 4)) * 64 + cs + (j & 15); }
            o += pbuf[idx] * bf2f(PROJ[(size_t)krow * NC + vcol + lane]);
        }
        const float z = bf2f(PROJ[(size_t)tok * NC + zcol + lane]);
        o *= z / (1.f + __expf(-z));
        OAB[(size_t)(which * M + tok) * 512 + h * 64 + lane] = (bf16)f2bf(o);
        LDS_WAIT(); asm volatile("" ::: "memory");
    }
}

__device__ __forceinline__ void final_norm_phase(const Args& a, int wave, int lane, int G) {
    const float* ssq = (const float*)(a.ws + WS_SSQ);
    const f32x4* gp = (const f32x4*)a.in[9] + lane;
    const int gw = blockIdx.x * NWAVES + wave, NGW = G * NWAVES;
    for (int m = gw; m < M; m += NGW) {
        float s = ssq[(size_t)m * 16 + (lane & 15)];
        s += __shfl_xor(s, 1); s += __shfl_xor(s, 2); s += __shfl_xor(s, 4); s += __shfl_xor(s, 8);
        const float rs = 1.f / sqrtf(s * (1.f / D) + RMS_EPS);
        f32x4* o = (f32x4*)(a.out + (size_t)m * D) + lane;
#pragma unroll
        for (int j = 0; j < 4; ++j) o[64 * j] = o[64 * j] * rs * gp[64 * j];
    }
}

__global__ void __launch_bounds__(NWAVES * 64, 2) fwd_kernel(Args a) {
    extern __shared__ __attribute__((aligned(16))) unsigned char lds_raw[];
    LAS unsigned char* lds = (LAS unsigned char*)lds_raw;
    cg::grid_group grid = cg::this_grid();
    const int tid = threadIdx.x, lane = tid & 63, wave = __builtin_amdgcn_readfirstlane(tid >> 6), G = gridDim.x;
    unsigned char* ws = a.ws;
    p0_prologue(a, lds, wave, lane, G);
    grid.sync();
    { pg8::Gemm g{(const pg8::bf16_t*)(ws + WS_XN), (const pg8::bf16_t*)(ws + WS_WIN), MP, NC, D};
      pg8::ProjOrder S; S.init(G, (int)blockIdx.x);
      pg8::EpiProj E{(pg8::bf16_t*)(ws + WS_PROJ), (const float*)(ws + WS_ROPE)};
      pg8::gemm_phase<pg8::EpiProj, pg8::ProjOrder, true, true>(lds, g, S, E); }
    grid.sync();
    naive_attn_phase(a, lds, wave, lane, G);
    grid.sync();
    { pg8::Gemm g{(const pg8::bf16_t*)(ws + WS_XN), (const pg8::bf16_t*)(ws + WS_WP), 2 * M, 2048, 512};
      pg8::MergeOrder S{G, (int)blockIdx.x};
      pg8::EpiMerge E{(const pg8::bf16_t*)(ws + WS_PROJ), (pg8::bf16_t*)(ws + WS_MG)};
      pg8::gemm_phase<pg8::EpiMerge, pg8::MergeOrder, true, true>(lds, g, S, E); }
    grid.sync();
    { pg8::Gemm g{(const pg8::bf16_t*)(ws + WS_MG), (const pg8::bf16_t*)(ws + WS_WO), M, D, D};
      pg8::StaticOrder S; S.init(M, D, G, (int)blockIdx.x);
      pg8::EpiOut E{a.in[0], a.out, (float*)(ws + WS_SSQ)};
      pg8::gemm_phase<pg8::EpiOut, pg8::StaticOrder, false, true>(lds, g, S, E); }
    grid.sync();
    final_norm_phase(a, wave, lane, G);
}

extern "C" void kernel_launch(void* const* d_in, const int* in_sizes, int n_in, void* d_out, int out_size, void* d_ws, size_t ws_size, hipStream_t stream) {
    static int grid = 0;
    if (grid == 0) {
        if (n_in != 10 || in_sizes[0] != M * D || out_size != M * D || ws_size < 256 * MiB) { fprintf(stderr, "kernel_launch: unexpected shapes (n_in %d, in0 %d, out %d, ws %zu)\n", n_in, n_in > 0 ? in_sizes[0] : -1, out_size, ws_size); grid = -1; return; }
        int dev = 0, cus = 0, per_cu = 0;
        (void)hipGetDevice(&dev); (void)hipDeviceGetAttribute(&cus, hipDeviceAttributeMultiprocessorCount, dev);
        if (hipFuncSetAttribute((const void*)fwd_kernel, hipFuncAttributeMaxDynamicSharedMemorySize, LDS_BYTES) != hipSuccess) { fprintf(stderr, "kernel_launch: hipFuncSetAttribute failed\n"); grid = -1; return; }
        if (hipOccupancyMaxActiveBlocksPerMultiprocessor(&per_cu, (const void*)fwd_kernel, NWAVES * 64, LDS_BYTES) != hipSuccess || per_cu < 1) { fprintf(stderr, "kernel_launch: occupancy query says %d\n", per_cu); per_cu = 1; }
        (void)hipGetLastError();
        grid = cus;
    }
    if (grid < 0) return;
    Args a{};
    for (int i = 0; i < 10; ++i) a.in[i] = (const float*)d_in[i];
    a.out = (float*)d_out; a.ws = (unsigned char*)d_ws;
    void* args[] = {&a};
    hipError_t e = hipLaunchCooperativeKernel((const void*)fwd_kernel, dim3(grid), dim3(NWAVES * 64), args, LDS_BYTES, stream);
    if (e != hipSuccess) fprintf(stderr, "cooperative launch failed: %s (grid %d)\n", hipGetErrorString(e), grid);
}
```

```cpp
#include <hip/hip_runtime.h>
#include <hip/hip_cooperative_groups.h>
#include <cstdio>
#include <cstdint>
namespace cg = cooperative_groups;
namespace pg8 {
#define PG8_LAS __attribute__((address_space(3)))
typedef unsigned short bf16_t;
typedef short bf16x8 __attribute__((ext_vector_type(8)));
typedef float f32x4 __attribute__((ext_vector_type(4)));
typedef unsigned u32x4 __attribute__((ext_vector_type(4)));
constexpr int BM = 256, BK = 64, HALF = 128, HTB = HALF * BK * 2  , STAGE_BYTES = 8 * HTB, NXCD = 8, WGM = 8;

__host__ __device__ __forceinline__ int lds_byte(int r, int c) { const int st = (r >> 4) * 2 + (c >> 5), rr = r & 15, cc = c & 31, ob = rr * 64 + cc * 2; return st * 1024 + (ob ^ (((ob >> 9) & 1) << 5)); }
__host__ __device__ __forceinline__ void stage_rc(int b, int& R, int& C) { const int st = b / 1024, sb = b % 1024, swz = sb ^ (((sb >> 9) & 1) << 5); R = (st >> 1) * 16 + swz / 64; C = (st & 1) * 32 + (swz % 64) / 2; }
__host__ __device__ __forceinline__ int perm32(int rho) { const int n = rho >> 4, i = rho & 15; return 8 * (i >> 2) + 4 * n + (i & 3); }

struct Unit { int pm, pn; };
struct Gemm { const bf16_t* A; const bf16_t* Bt; int M, N, K; };

struct StaticOrder {
    int nM, nN, nwg, G, c;
    __host__ __device__ void init(int M, int N, int G_, int c_) { nM = M / BM; nN = N / BM; nwg = nM * nN; G = G_; c = c_; }
    __host__ __device__ bool next(int i, Unit& u) const {
        const long L = (long)i * G + c; if (L >= nwg) return false;
        int wgid = (int)L; { const int q = nwg / NXCD, r = nwg % NXCD, xcd = wgid % NXCD, off = wgid / NXCD; wgid = (xcd < r ? xcd * (q + 1) : r * (q + 1) + (xcd - r) * q) + off; }
        const int nig = WGM * nN, gid = wgid / nig, fm = gid * WGM, gsz = (nM - fm) < WGM ? (nM - fm) : WGM;
        u.pm = fm + ((wgid % nig) % gsz); u.pn = (wgid % nig) / gsz; return true;
    }
    __device__ __forceinline__ void a_ready(const Unit&) const {}
    __device__ __forceinline__ void done(const Unit&) const {}
};
__device__ __forceinline__ unsigned cvt_pk_bf16(float lo, float hi) { unsigned r; asm volatile("v_cvt_pk_bf16_f32 %0, %1, %2" : "=v"(r) : "v"(lo), "v"(hi)); return r; }
constexpr int PROJ_LD = 5376;
constexpr float QSCALE = 0.18033688011112042f;
__device__ __forceinline__ float bfl(unsigned u) { return __builtin_bit_cast(float, u << 16); }
__device__ __forceinline__ float bfh(unsigned u) { return __builtin_bit_cast(float, u & 0xffff0000u); }
__device__ __forceinline__ float sigmoidf_(float x) { return 1.f / (1.f + __expf(-x)); }

struct EpiProj {
    static constexpr bool PERM = true, AFTER_DRAIN = false;
    bf16_t* O; const float* rope;
    __device__ __forceinline__ void operator()(const f32x4 (&acc)[2][2][4][2], const Unit& u, int wr, int wc, int fr, int fq) const {
        const int pn = u.pn;
        const bool rope_t = (pn <= 2) && ((wc & 1) == 0);
        const float sc = (pn <= 1 || pn == 5 || pn == 6) ? QSCALE : 1.f;
        const int row0 = u.pm * BM + wr * 64 + fr, col0 = pn * BM + wc * 32 + 8 * fq;
#pragma unroll
        for (int ai = 0; ai < 2; ++ai)
#pragma unroll
            for (int m = 0; m < 4; ++m) {
                const int row = row0 + ai * HALF + m * 16;
                f32x4 c0 = {1.f, 1.f, 1.f, 1.f}, c1 = c0, s0 = {0.f, 0.f, 0.f, 0.f}, s1 = s0;
                if (rope_t) { const int pos = row < 16384 ? (row & 8191) + 16 : row - 16384; const f32x4* rp = (const f32x4*)(rope + (size_t)pos * 16);
                    c0 = rp[0]; c1 = rp[1]; s0 = rp[2]; s1 = rp[3]; }
                bf16_t* rowp = O + (size_t)row * PROJ_LD + col0;
#pragma unroll
                for (int bj = 0; bj < 2; ++bj) {
                    f32x4 v0 = acc[ai][bj][m][0], v1 = acc[ai][bj][m][1];
                    if (rope_t && (pn < 2 || bj == 0)) {
                        f32x4 p0, p1;
#pragma unroll
                        for (int i = 0; i < 4; ++i) { p0[i] = __shfl_xor(v0[i], 16); p1[i] = __shfl_xor(v1[i], 16); }
                        if (fq == 0) { v0 = v0 * c0 - p0 * s0; v1 = v1 * c1 - p1 * s1; }
                        else if (fq == 1) { v0 = v0 * c0 + p0 * s0; v1 = v1 * c1 + p1 * s1; }
                    }
                    v0 = v0 * sc; v1 = v1 * sc;
                    u32x4 w; w.x = cvt_pk_bf16(v0[0], v0[1]); w.y = cvt_pk_bf16(v0[2], v0[3]); w.z = cvt_pk_bf16(v1[0], v1[1]); w.w = cvt_pk_bf16(v1[2], v1[3]);
                    *(u32x4*)(rowp + bj * HALF) = w;
                }
            }
    }
};

struct EpiMerge {
    static constexpr bool PERM = true, AFTER_DRAIN = false;
    const bf16_t* proj; bf16_t* merged;
    __device__ __forceinline__ void operator()(const f32x4 (&acc)[2][2][4][2], const Unit& u, int wr, int wc, int fr, int fq) const {
        const int part = u.pn >= 4 ? 1 : 0, pm = u.pm - 64 * part, pn = u.pn - 4 * part;
        const int row0 = pm * BM + wr * 64 + fr, col0 = pn * BM + wc * 32 + 8 * fq;
        const int gcol = (part ? 4352 : 3328) + col0;
#pragma unroll
        for (int ai = 0; ai < 2; ++ai)
#pragma unroll
            for (int m = 0; m < 4; ++m) {
                const int row = row0 + ai * HALF + m * 16;
#pragma unroll
                for (int bj = 0; bj < 2; ++bj) {
                    const u32x4 g = *(const u32x4*)(proj + (size_t)row * PROJ_LD + gcol + bj * HALF);
                    bf16_t* mp = merged + (size_t)row * 1024 + col0 + bj * HALF;
                    const f32x4 a0 = acc[ai][bj][m][0], a1 = acc[ai][bj][m][1];
                    float v[8];
                    v[0] = sigmoidf_(bfl(g.x)) * a0[0]; v[1] = sigmoidf_(bfh(g.x)) * a0[1]; v[2] = sigmoidf_(bfl(g.y)) * a0[2]; v[3] = sigmoidf_(bfh(g.y)) * a0[3];
                    v[4] = sigmoidf_(bfl(g.z)) * a1[0]; v[5] = sigmoidf_(bfh(g.z)) * a1[1]; v[6] = sigmoidf_(bfl(g.w)) * a1[2]; v[7] = sigmoidf_(bfh(g.w)) * a1[3];
                    if (part) { const u32x4 p = *(const u32x4*)mp;
                        v[0] += bfl(p.x); v[1] += bfh(p.x); v[2] += bfl(p.y); v[3] += bfh(p.y); v[4] += bfl(p.z); v[5] += bfh(p.z); v[6] += bfl(p.w); v[7] += bfh(p.w); }
                    u32x4 w; w.x = cvt_pk_bf16(v[0], v[1]); w.y = cvt_pk_bf16(v[2], v[3]); w.z = cvt_pk_bf16(v[4], v[5]); w.w = cvt_pk_bf16(v[6], v[7]);
                    *(u32x4*)mp = w;
                }
            }
    }
};

struct EpiOut {
    static constexpr bool PERM = true, AFTER_DRAIN = false;
    const float* x; float* out; float* ssq;
    __device__ __forceinline__ void operator()(const f32x4 (&acc)[2][2][4][2], const Unit& u, int wr, int wc, int fr, int fq) const {
        const int row0 = u.pm * BM + wr * 64 + fr, col0 = u.pn * BM + wc * 32 + 8 * fq;
#pragma unroll
        for (int ai = 0; ai < 2; ++ai)
#pragma unroll
            for (int m = 0; m < 4; ++m) {
                const int row = row0 + ai * HALF + m * 16; float s = 0.f;
#pragma unroll
                for (int bj = 0; bj < 2; ++bj) {
                    const size_t o = (size_t)row * 1024 + col0 + bj * HALF;
                    const f32x4 h0 = *(const f32x4*)(x + o) + acc[ai][bj][m][0], h1 = *(const f32x4*)(x + o + 4) + acc[ai][bj][m][1];
                    *(f32x4*)(out + o) = h0; *(f32x4*)(out + o + 4) = h1;
                    s += (h0[0] * h0[0] + h0[1] * h0[1]) + (h0[2] * h0[2] + h0[3] * h0[3]) + (h1[0] * h1[0] + h1[1] * h1[1]) + (h1[2] * h1[2] + h1[3] * h1[3]);
                }
                s += __shfl_xor(s, 16); s += __shfl_xor(s, 32);
                if (fq == 0) ssq[(size_t)row * 16 + u.pn * 4 + wc] = s;
            }
    }
};

struct ProjOrder {
    StaticOrder so; int G, c;
    __device__ void init(int G_, int c_) { so.init(16384, 5376, G_, c_); G = G_; c = c_; }
    __device__ bool next(int i, Unit& u) const {
        const long L = (long)i * G + c;
        if (L < 1344) return so.next(i, u);
        const int e = (int)(L - 1344); if (e >= 5) return false;
        u.pm = 64; u.pn = e == 0 ? 2 : 6 + e; return true;
    }
    __device__ __forceinline__ void a_ready(const Unit&) const {}
    __device__ __forceinline__ void done(const Unit&) const {}
};
struct MergeOrder {
    int G, c;
    __device__ bool next(int i, Unit& u) const {
        const int T = c + (i >> 1) * G; if (T >= 256) return false;
        const int part = i & 1, x = T & 7, o = T >> 3;
        u.pm = 8 * x + (o & 7) + 64 * part; u.pn = (o >> 3) + 4 * part; return true;
    }
    __device__ __forceinline__ void a_ready(const Unit&) const {}
    __device__ __forceinline__ void done(const Unit&) const {}
};
template <class Epi, class Sched, bool ALIGN_EPI = false, bool SP2 = false>
__device__ __forceinline__ void gemm_phase(PG8_LAS unsigned char* lds, const Gemm g, const Sched& S, const Epi& E) {
    const int tid = threadIdx.x, wid = __builtin_amdgcn_readfirstlane(tid >> 6), lane = tid & 63, wr = wid >> 2, wc = wid & 3, fr = lane & 15, fq = lane >> 4;
    const int K = g.K, nt = K / BK;
    unsigned voffA[2], voffB[2];
#pragma unroll
    for (int i = 0; i < 2; ++i) { int R, C; stage_rc(tid * 16 + i * 8192, R, C); const int Rb = Epi::PERM ? ((R & ~31) + perm32(R & 31)) : R;
        voffA[i] = (unsigned)(R * K + C) * 2u; voffB[i] = (unsigned)(Rb * K + C) * 2u; }
    const size_t kstep = (size_t)(BK * 2);
    const size_t hstep = (size_t)HALF * K * 2;
    const size_t tstep = 2 * hstep;
    const unsigned ldsw = (unsigned)wid * 1024u;
    const int aoff = lds_byte(wr * 64 + fr, fq * 8), boff = lds_byte(wc * 32 + fr, fq * 8);
#define PG8_SA(b, h) (((b) * 2 + (h)) * HTB)
#define PG8_SB(b, h) ((4 + (b) * 2 + (h)) * HTB)
#define PG8_STAGE(bufoff, gbase, voff) do { _Pragma("unroll") for (int _i = 0; _i < 2; ++_i) \
        __builtin_amdgcn_global_load_lds((const unsigned*)((const char*)(gbase) + (voff)[_i]), (PG8_LAS unsigned*)(lds + (bufoff) + ldsw + _i * 8192), 16, 0, 0); } while (0)
#define PG8_LDA(dst, b, h) do { _Pragma("unroll") for (int m = 0; m < 4; ++m) _Pragma("unroll") for (int k = 0; k < 2; ++k) dst[m][k] = *(const PG8_LAS bf16x8*)(lds + PG8_SA(b, h) + aoff + m * 2048 + k * 1024); } while (0)
#define PG8_LDB(dst, b, h) do { _Pragma("unroll") for (int n = 0; n < 2; ++n) _Pragma("unroll") for (int k = 0; k < 2; ++k) dst[n][k] = *(const PG8_LAS bf16x8*)(lds + PG8_SB(b, h) + boff + n * 2048 + k * 1024); } while (0)
#define PG8_MMA(ai, bj, At, Bt) do { __builtin_amdgcn_s_setprio(1); _Pragma("unroll") for (int m = 0; m < 4; ++m) _Pragma("unroll") for (int n = 0; n < 2; ++n) _Pragma("unroll") for (int k = 0; k < 2; ++k) \
        acc[ai][bj][m][n] = __builtin_amdgcn_mfma_f32_16x16x32_bf16(Bt[n][k], At[m][k], acc[ai][bj][m][n], 0, 0, 0); __builtin_amdgcn_s_setprio(0); } while (0)
#define PG8_WAIT_V(n) asm volatile("s_waitcnt vmcnt(" #n ")" ::: "memory")
#define PG8_WAIT_L(n) asm volatile("s_waitcnt lgkmcnt(" #n ")" ::: "memory")
#define PG8_BAR __builtin_amdgcn_s_barrier()
#define PG8_SCHED __builtin_amdgcn_sched_barrier(0)
    Unit cur, nxt; int ui = 0;
    if (!S.next(0, cur)) return;
    f32x4 acc[2][2][4][2];
#pragma unroll
    for (int a = 0; a < 2; ++a)
#pragma unroll
        for (int b = 0; b < 2; ++b)
#pragma unroll
            for (int m = 0; m < 4; ++m)
#pragma unroll
                for (int n = 0; n < 2; ++n) acc[a][b][m][n] = (f32x4){0.f, 0.f, 0.f, 0.f};
    bf16x8 At[4][2], B0[2][2], B1[2][2];
    const char* cA = (const char*)g.A + (size_t)cur.pm * tstep; const char* cB = (const char*)g.Bt + (size_t)cur.pn * tstep;
    S.a_ready(cur);
    if constexpr (SP2) {
        PG8_STAGE(PG8_SB(0, 0), cB, voffB); PG8_STAGE(PG8_SB(0, 1), cB + hstep, voffB); PG8_STAGE(PG8_SA(0, 0), cA, voffA); PG8_STAGE(PG8_SA(0, 1), cA + hstep, voffA);
        if (wr == 1) PG8_BAR;
        PG8_WAIT_V(2); PG8_BAR;
        PG8_STAGE(PG8_SB(1, 0), cB + kstep, voffB); PG8_STAGE(PG8_SA(1, 0), cA + kstep, voffA); PG8_STAGE(PG8_SB(1, 1), cB + hstep + kstep, voffB);
        PG8_WAIT_V(6); PG8_BAR;
    } else {
        PG8_STAGE(PG8_SB(0, 0), cB, voffB); PG8_STAGE(PG8_SA(0, 0), cA, voffA); PG8_STAGE(PG8_SB(0, 1), cB + hstep, voffB); PG8_STAGE(PG8_SA(0, 1), cA + hstep, voffA);
        if (wr == 1) PG8_BAR;
        PG8_WAIT_V(4); PG8_BAR;
        PG8_STAGE(PG8_SB(1, 0), cB + kstep, voffB); PG8_STAGE(PG8_SA(1, 0), cA + kstep, voffA); PG8_STAGE(PG8_SB(1, 1), cB + hstep + kstep, voffB);
        PG8_WAIT_V(6); PG8_BAR;
    }
    for (;;) {
        const bool has_next = S.next(ui + 1, nxt);
        const char* nA = has_next ? (const char*)g.A + (size_t)nxt.pm * tstep : cA; const char* nB = has_next ? (const char*)g.Bt + (size_t)nxt.pn * tstep : cB;
        for (int t = 0; t < nt; t += 2) {
            const bool last = (t == nt - 2);
            const char* a1 = cA + (size_t)(t + 1) * kstep;
            const char* a2 = last ? nA : cA + (size_t)(t + 2) * kstep; const char* b2 = last ? nB : cB + (size_t)(t + 2) * kstep;
            const char* a3 = a2 + kstep; const char* b3 = b2 + kstep;
            if (last && has_next) S.a_ready(nxt);
            if constexpr (SP2) {
            PG8_LDB(B0, 0, 0); PG8_LDB(B1, 0, 1); PG8_SCHED; PG8_LDA(At, 0, 0); PG8_STAGE(PG8_SA(1, 1), a1 + hstep, voffA);
            PG8_WAIT_V(8); PG8_WAIT_L(0); PG8_BAR; PG8_MMA(0, 0, At, B0); PG8_MMA(0, 1, At, B1); PG8_BAR; PG8_SCHED;
            PG8_LDA(At, 0, 1); PG8_STAGE(PG8_SB(0, 0), b2, voffB); PG8_STAGE(PG8_SB(0, 1), b2 + hstep, voffB); PG8_STAGE(PG8_SA(0, 0), a2, voffA);
            PG8_WAIT_V(8); PG8_WAIT_L(0); PG8_BAR; PG8_MMA(1, 0, At, B0); PG8_MMA(1, 1, At, B1); PG8_BAR; PG8_SCHED;
            PG8_LDB(B0, 1, 0); PG8_LDB(B1, 1, 1); PG8_SCHED; PG8_LDA(At, 1, 0); PG8_STAGE(PG8_SA(0, 1), a2 + hstep, voffA);
            PG8_WAIT_V(8); PG8_WAIT_L(0); PG8_BAR; PG8_MMA(0, 0, At, B0); PG8_MMA(0, 1, At, B1); PG8_BAR; PG8_SCHED;
            PG8_LDA(At, 1, 1); PG8_STAGE(PG8_SB(1, 0), b3, voffB); PG8_STAGE(PG8_SB(1, 1), b3 + hstep, voffB); PG8_STAGE(PG8_SA(1, 0), a3, voffA);
            PG8_WAIT_V(8); PG8_WAIT_L(0); PG8_BAR; PG8_MMA(1, 0, At, B0); PG8_MMA(1, 1, At, B1); PG8_BAR; PG8_SCHED;
            } else {
            PG8_LDB(B0, 0, 0); PG8_SCHED; PG8_LDA(At, 0, 0); PG8_STAGE(PG8_SA(1, 1), a1 + hstep, voffA);
            PG8_WAIT_L(8); PG8_BAR; PG8_WAIT_L(0); PG8_MMA(0, 0, At, B0); PG8_BAR; PG8_SCHED;
            PG8_LDB(B1, 0, 1); PG8_STAGE(PG8_SB(0, 0), b2, voffB);
            PG8_BAR; PG8_WAIT_L(0); PG8_MMA(0, 1, At, B1); PG8_BAR;
            PG8_LDA(At, 0, 1); PG8_STAGE(PG8_SA(0, 0), a2, voffA);
            PG8_BAR; PG8_WAIT_L(0); PG8_MMA(1, 0, At, B0); PG8_BAR; PG8_SCHED;
            PG8_STAGE(PG8_SB(0, 1), b2 + hstep, voffB);
            PG8_WAIT_V(6); PG8_BAR; PG8_MMA(1, 1, At, B1); PG8_BAR;
            PG8_LDB(B0, 1, 0); PG8_SCHED; PG8_LDA(At, 1, 0); PG8_STAGE(PG8_SA(0, 1), a2 + hstep, voffA);
            PG8_WAIT_L(8); PG8_BAR; PG8_WAIT_L(0); PG8_MMA(0, 0, At, B0); PG8_BAR; PG8_SCHED;
            PG8_LDB(B1, 1, 1); PG8_STAGE(PG8_SB(1, 0), b3, voffB);
            PG8_BAR; PG8_WAIT_L(0); PG8_MMA(0, 1, At, B1); PG8_BAR;
            PG8_LDA(At, 1, 1); PG8_STAGE(PG8_SA(1, 0), a3, voffA);
            PG8_BAR; PG8_WAIT_L(0); PG8_MMA(1, 0, At, B0); PG8_BAR; PG8_SCHED;
            PG8_STAGE(PG8_SB(1, 1), b3 + hstep, voffB);
            PG8_WAIT_V(6); PG8_BAR; PG8_MMA(1, 1, At, B1); PG8_BAR;
            }
        }
        if constexpr (ALIGN_EPI) { if (wr == 0) PG8_BAR; }
        if constexpr (!Epi::AFTER_DRAIN) { E(acc, cur, wr, wc, fr, fq); S.done(cur); }
        if (!has_next) break;
#pragma unroll
        for (int a = 0; a < 2; ++a)
#pragma unroll
            for (int b = 0; b < 2; ++b)
#pragma unroll
                for (int m = 0; m < 4; ++m)
#pragma unroll
                    for (int n = 0; n < 2; ++n) acc[a][b][m][n] = (f32x4){0.f, 0.f, 0.f, 0.f};
        cur = nxt; cA = nA; cB = nB; ++ui;
        if constexpr (ALIGN_EPI) { if (wr == 1) PG8_BAR; }
    }
    PG8_WAIT_V(0);
    if constexpr (!ALIGN_EPI) { if (wr == 0) PG8_BAR; }
    PG8_BAR;
    if constexpr (Epi::AFTER_DRAIN) { E.fused(acc, cur, wr, wc, fr, fq, lds, wid, lane); S.done(cur); }
#undef PG8_SA
#undef PG8_SB
#undef PG8_STAGE
#undef PG8_LDA
#undef PG8_LDB
#undef PG8_MMA
#undef PG8_WAIT_V
#undef PG8_WAIT_L
#undef PG8_BAR
#undef PG8_SCHED
}
}
#define GAS __attribute__((address_space(1)))
#define LAS __attribute__((address_space(3)))
typedef unsigned short bf16;
typedef unsigned v4u __attribute__((ext_vector_type(4)));
typedef unsigned v2u __attribute__((ext_vector_type(2)));
typedef float f32x4 __attribute__((ext_vector_type(4)));
typedef short bf16x8 __attribute__((ext_vector_type(8)));
constexpr int NWAVES = 8;
constexpr int M = 16384, D = 1024, NC = 5376, MP = 16640, SEQ = 8192, NMETA = 16, LPOS = SEQ + NMETA;
constexpr int C_QA = 0, C_KA = 512, C_VA = 640, C_ZA = 768, C_QB = 1280, C_KB = 1792, C_VB = 2304, C_ZB = 2816, C_GA = 3328, C_GB = 4352;
constexpr float RMS_EPS = 1e-6f, LOG2E = 1.4426950408889634f;
constexpr size_t MiB = 1u << 20;
constexpr size_t WS_WIN = 1 * MiB, WS_WP = 12 * MiB, WS_WO = 14 * MiB, WS_ROPE = 16 * MiB, WS_SSQ = 17 * MiB, WS_XN = 18 * MiB, WS_MG = 51 * MiB, WS_PROJ = 84 * MiB;
static_assert(WS_XN + (size_t)MP * D * 2 <= WS_MG && WS_MG + (size_t)M * D * 2 <= WS_PROJ && WS_PROJ + (size_t)MP * NC * 2 <= 256 * MiB, "ws map");
constexpr int LDS_BYTES = 163840 - 4096;
#define LDS_WAIT() asm volatile("s_waitcnt lgkmcnt(0)" ::: "memory")
__device__ __forceinline__ unsigned f2bf(float f) { unsigned u = __builtin_bit_cast(unsigned, f); return (u + 0x7fffu + ((u >> 16) & 1u)) >> 16; }
__device__ __forceinline__ unsigned pk2(float lo, float hi) { return f2bf(lo) | (f2bf(hi) << 16); }
__device__ __forceinline__ float bf2f(unsigned short h) { return __builtin_bit_cast(float, (unsigned)h << 16); }
__device__ __forceinline__ float wave_sum(float v) {
#pragma unroll
    for (int o = 1; o < 64; o <<= 1) v += __shfl_xor(v, o);
    return v;
}
__device__ __forceinline__ float wave_max(float v) {
#pragma unroll
    for (int o = 1; o < 64; o <<= 1) v = fmaxf(v, __shfl_xor(v, o));
    return v;
}

struct Args { const float* in[10]; float* out; unsigned char* ws; };

__device__ __forceinline__ void p0_transpose_item(const float* W, int K, int N, bf16* WT, int row_off, LAS float* scr, int item, int lane) {
    const int nblk = N / 32, kb = item / nblk, nb = item % nblk, k0 = 64 * kb, n0 = 32 * nb;
#pragma unroll 8
    for (int i = 0; i < 32; ++i) { const int kk = 2 * i + (lane >> 5); scr[kk * 33 + (lane & 31)] = W[(size_t)(k0 + kk) * N + n0 + (lane & 31)]; }
    LDS_WAIT(); asm volatile("" ::: "memory");
    const int c = lane & 7;
#pragma unroll
    for (int j = 0; j < 4; ++j) { const int n = (lane >> 3) + 8 * j; const LAS float* s = scr + (8 * c) * 33 + n;
        v4u o; o.x = pk2(s[0 * 33], s[1 * 33]); o.y = pk2(s[2 * 33], s[3 * 33]); o.z = pk2(s[4 * 33], s[5 * 33]); o.w = pk2(s[6 * 33], s[7 * 33]);
        *(v4u*)(WT + (size_t)(row_off + n0 + n) * K + k0 + 8 * c) = o; }
    LDS_WAIT(); asm volatile("" ::: "memory");
}

__device__ __forceinline__ void p0_prologue(const Args& a, LAS unsigned char* lds, int wave, int lane, int G) {
    unsigned char* ws = a.ws;
    LAS float* scr = (LAS float*)(lds + wave * 16384);
    const int gw = blockIdx.x * NWAVES + wave, NGW = G * NWAVES;
    constexpr int I_IN = (D / 64) * (NC / 32), I_PA = (512 / 64) * (D / 32), I_O = (D / 64) * (D / 32);
    constexpr int NITEMS = I_IN + 2 * I_PA + I_O;
    for (int it = gw; it < NITEMS; it += NGW) {
        int r = it;
        if (r < I_IN) { p0_transpose_item(a.in[3], D, NC, (bf16*)(ws + WS_WIN), 0, scr, r, lane); continue; } r -= I_IN;
        if (r < I_PA) { p0_transpose_item(a.in[6], 512, D, (bf16*)(ws + WS_WP), 0, scr, r, lane); continue; } r -= I_PA;
        if (r < I_PA) { p0_transpose_item(a.in[7], 512, D, (bf16*)(ws + WS_WP), 1024, scr, r, lane); continue; } r -= I_PA;
        p0_transpose_item(a.in[8], D, D, (bf16*)(ws + WS_WO), 0, scr, r, lane);
    }
    bf16* XN = (bf16*)(ws + WS_XN);
    const f32x4* gp = (const f32x4*)a.in[2] + lane;
    for (int m = gw; m < MP; m += NGW) {
        unsigned long long* o8 = (unsigned long long*)(XN + (size_t)m * D) + lane;
        if (m >= M + NMETA) {
#pragma unroll
            for (int j = 0; j < 4; ++j) o8[64 * j] = 0ull;
            continue;
        }
        const float* xrow = m < M ? a.in[0] + (size_t)m * D : a.in[1] + (size_t)(m - M) * D;
        const f32x4* xr = (const f32x4*)xrow + lane;
        f32x4 v[4]; float s = 0.f;
#pragma unroll
        for (int j = 0; j < 4; ++j) { v[j] = xr[64 * j]; s += (v[j].x * v[j].x + v[j].y * v[j].y) + (v[j].z * v[j].z + v[j].w * v[j].w); }
        const float rs = 1.f / sqrtf(wave_sum(s) * (1.f / D) + RMS_EPS);
#pragma unroll
        for (int j = 0; j < 4; ++j) { const f32x4 g = gp[64 * j]; const f32x4 y = v[j] * rs * g;
            o8[64 * j] = (unsigned long long)pk2(y.x, y.y) | ((unsigned long long)pk2(y.z, y.w) << 32); }
    }
    float* rope = (float*)(ws + WS_ROPE);
    const float inv_freq[8] = {1.0f, 0.19392274474868576f, 0.03760603093086393f, 0.007292664737217109f, 0.001414213562373095f, 0.0002742481756762073f, 5.318295896944988e-05f, 1.031338537721246e-05f};
    for (int pos = (int)threadIdx.x * G + (int)blockIdx.x; pos < LPOS; pos += G * 512) {
#pragma unroll
        for (int j = 0; j < 8; ++j) {
            const float ang = (float)pos * inv_freq[j];
            const double x = (double)ang, kq = __builtin_rint(x * 0.15915494309189535), r = x - kq * 6.283185307179586, r2 = r * r;
            double ts = 1.0, tc = 1.0, sn = 1.0, cs = 1.0;
#pragma unroll
            for (int n = 1; n <= 15; ++n) { tc *= r2 * (-1.0 / (double)((2 * n - 1) * (2 * n))); ts *= r2 * (-1.0 / (double)((2 * n) * (2 * n + 1))); cs += tc; sn += ts; }
            sn *= r;
            rope[pos * 16 + j] = (float)cs; rope[pos * 16 + 8 + j] = (float)sn;
        }
    }
}

__device__ __forceinline__ void naive_attn_phase(const Args& a, LAS unsigned char* lds, int wave, int lane, int G, int wlo, int whi) {
    const bf16* PROJ = (const bf16*)(a.ws + WS_PROJ);
    bf16* OAB = (bf16*)(a.ws + WS_XN);
    const float* sink = a.in[4]; const float* rpb = a.in[5];
    LAS float* pbuf = (LAS float*)(lds + wave * 2048);
    const int gw = blockIdx.x * NWAVES + wave, NGW = G * NWAVES;
    for (int it = gw + wlo * M * 8; it < whi * M * 8; it += NGW) {
        const int which = it >= M * 8 ? 1 : 0, r = it - which * M * 8, tok = r >> 3, h = r & 7, b = tok >> 13, t = tok & 8191;
        int qcol, kcol, vcol, zcol, nloc, t0 = 0, gr = 0, gc = 0, rs = 0, cs = 0;
        if (!which) { const int kvh = h >> 2; qcol = C_QA + h * 64; kcol = C_KA + kvh * 64; vcol = C_VA + kvh * 64; zcol = C_ZA + h * 64;
            t0 = t - 128 < 0 ? 0 : t - 128; const int t1 = t + 128 > SEQ - 1 ? SEQ - 1 : t + 128; nloc = t1 - t0 + 1; }
        else { qcol = C_QB + h * 64; kcol = C_KB + h * 64; vcol = C_VB + h * 64; zcol = C_ZB + h * 64; nloc = 128; gr = t >> 6; gc = t & 63;
            rs = gr - 4 < 0 ? 0 : (gr - 4 > 120 ? 120 : gr - 4); cs = gc - 8 < 0 ? 0 : (gc - 8 > 48 ? 48 : gc - 8); }
        const int nk = 16 + nloc;
        v4u qv[8];
        { const v4u* qp = (const v4u*)(PROJ + (size_t)tok * NC + qcol);
#pragma unroll
          for (int i = 0; i < 8; ++i) qv[i] = qp[i]; }
        float sv[5]; float mx = which ? -1e30f : sink[h] * LOG2E;
#pragma unroll
        for (int jj = 0; jj < 5; ++jj) {
            const int idx = lane + 64 * jj; float s = -1e30f;
            if (idx < nk) {
                int krow; float bias = 0.f;
                if (idx < 16) krow = M + idx;
                else if (!which) krow = b * SEQ + t0 + (idx - 16);
                else { const int j = idx - 16, kr = j >> 4, kc = j & 15; krow = b * SEQ + (rs + kr) * 64 + cs + kc;
                    bias = rpb[(h * 15 + (rs + kr - gr + 7)) * 31 + (cs + kc - gc + 15)] * LOG2E; }
                const v4u* kp = (const v4u*)(PROJ + (size_t)krow * NC + kcol);
                float acc = 0.f;
#pragma unroll
                for (int i = 0; i < 8; ++i) { const v4u kv = kp[i]; const v4u q = qv[i];
                    acc += pg8::bfl(q.x) * pg8::bfl(kv.x) + pg8::bfh(q.x) * pg8::bfh(kv.x) + pg8::bfl(q.y) * pg8::bfl(kv.y) + pg8::bfh(q.y) * pg8::bfh(kv.y)
                         + pg8::bfl(q.z) * pg8::bfl(kv.z) + pg8::bfh(q.z) * pg8::bfh(kv.z) + pg8::bfl(q.w) * pg8::bfl(kv.w) + pg8::bfh(q.w) * pg8::bfh(kv.w); }
                s = acc + bias;
            }
            sv[jj] = s; mx = fmaxf(mx, s);
        }
        mx = wave_max(mx);
        float l = 0.f;
#pragma unroll
        for (int jj = 0; jj < 5; ++jj) { const int idx = lane + 64 * jj; const float p = idx < nk ? exp2f(sv[jj] - mx) : 0.f; sv[jj] = p; l += p; }
        l = wave_sum(l); if (!which) l += exp2f(sink[h] * LOG2E - mx);
        const float inv = 1.f / l;
#pragma unroll
        for (int jj = 0; jj < 5; ++jj) { const int idx = lane + 64 * jj; if (idx < nk) pbuf[idx] = sv[jj] * inv; }
        LDS_WAIT(); asm volatile("" ::: "memory");
        float o = 0.f;
        for (int idx = 0; idx < nk; ++idx) {
            int krow;
            if (idx < 16) krow = M + idx;
            else if (!which) krow = b * SEQ + t0 + (idx - 16);
            else { const int j = idx - 16; krow = b * SEQ + (rs + (j >> 4)) * 64 + cs + (j & 15); }
            o += pbuf[idx] * bf2f(PROJ[(size_t)krow * NC + vcol + lane]);
        }
        const float z = bf2f(PROJ[(size_t)tok * NC + zcol + lane]);
        o *= z / (1.f + __expf(-z));
        OAB[(size_t)(which * M + tok) * 512 + h * 64 + lane] = (bf16)f2bf(o);
        LDS_WAIT(); asm volatile("" ::: "memory");
    }
}


typedef short s16x4 __attribute__((ext_vector_type(4)));
constexpr float NEG_BIG = -1e30f;
__device__ __forceinline__ int kvoff(int row, int c16) { return row * 128 + ((c16 ^ ((row >> 1) & 7)) << 4); }
__device__ __forceinline__ s16x4 vtr(LAS unsigned char* p) { return __builtin_amdgcn_ds_read_tr16_b64_v4i16((LAS s16x4*)p); }
__device__ __forceinline__ float ex2(float x) { return __builtin_amdgcn_exp2f(x); }
typedef float f32x2_t __attribute__((ext_vector_type(2))); typedef __bf16 bf16x2_t __attribute__((ext_vector_type(2)));
__device__ __forceinline__ unsigned cvtpk_s(float lo, float hi) { f32x2_t v = {lo, hi}; bf16x2_t b = __builtin_convertvector(v, bf16x2_t); return __builtin_bit_cast(unsigned, b); }
__device__ __forceinline__ bf16x8 pack_p(const f32x4& a, const f32x4& b) {
    v4u w; w.x = cvtpk_s(a[0], a[1]); w.y = cvtpk_s(a[2], a[3]); w.z = cvtpk_s(b[0], b[1]); w.w = cvtpk_s(b[2], b[3]);
    return __builtin_bit_cast(bf16x8, w);
}
__device__ __forceinline__ bf16x8 vfrag(LAS unsigned char* Vs, int row, int db, int p) {
    const int c16 = 2 * db + (p >> 1), h8 = (p & 1) * 8;
    const s16x4 lo = vtr(Vs + kvoff(row, c16) + h8), hi = vtr(Vs + kvoff(row + 16, c16) + h8);
    return (bf16x8){lo[0], lo[1], lo[2], lo[3], hi[0], hi[1], hi[2], hi[3]};
}
__device__ __forceinline__ float silu_(float z) { return z / (1.f + __expf(-z)); }

__device__ __forceinline__ void attn_a_phase(const Args& a, LAS unsigned char* lds, int tid, int wave, int lane, int G) {
    const bf16* PROJ = (const bf16*)(a.ws + WS_PROJ);
    bf16* OAB = (bf16*)(a.ws + WS_XN);
    constexpr int KROWS = 352;
    LAS unsigned char* Ks = lds; LAS unsigned char* Vs = lds + KROWS * 128;
    const int li = lane & 15, kg = lane >> 4, qp = li >> 2, pp = li & 3;
    __syncthreads();
    if (tid < 128) { const v4u z = {0u, 0u, 0u, 0u}; *(LAS v4u*)(Ks + 16 * 128 + tid * 16) = z; *(LAS v4u*)(Vs + 16 * 128 + tid * 16) = z; }
    for (int item = blockIdx.x; item < 512; item += G) {
        const int qt = item & 127, kvh = (item >> 7) & 1, b = item >> 8, tbase = qt * 64 - 128;
        __syncthreads();
        {
            v4u mv = {0u, 0u, 0u, 0u}; const int mw = tid >> 7, mp = tid & 127, mrow = mp >> 3, mc = mp & 7;
            if (tid < 256) mv = *(const v4u*)(PROJ + (size_t)(M + mrow) * NC + (mw ? C_VA : C_KA) + kvh * 64 + mc * 8);
            v4u kv[5], vv[5];
#pragma unroll
            for (int i = 0; i < 5; ++i) { const int p = tid + 512 * i, rr = p >> 3, c16 = p & 7, tok = tbase + rr;
                if (tok >= 0 && tok < SEQ) { const bf16* src = PROJ + (size_t)(b * SEQ + tok) * NC + kvh * 64 + c16 * 8; kv[i] = *(const v4u*)(src + C_KA); vv[i] = *(const v4u*)(src + C_VA); }
                else { kv[i] = (v4u){0u, 0u, 0u, 0u}; vv[i] = kv[i]; } }
            if (tid < 256) *(LAS v4u*)((mw ? Vs : Ks) + kvoff(mrow, mc)) = mv;
#pragma unroll
            for (int i = 0; i < 5; ++i) { const int p = tid + 512 * i, rr = p >> 3, c16 = p & 7; const int o = kvoff(32 + rr, c16);
                *(LAS v4u*)(Ks + o) = kv[i]; *(LAS v4u*)(Vs + o) = vv[i]; }
        }
        __syncthreads();
        const int hq = kvh * 4 + (wave & 3), qh = wave >> 2, tq0 = qt * 64 + qh * 32;
        bf16x8 Qf[2][2];
#pragma unroll
        for (int qb = 0; qb < 2; ++qb)
#pragma unroll
            for (int s = 0; s < 2; ++s) Qf[qb][s] = *(const bf16x8*)(PROJ + (size_t)(b * SEQ + tq0 + 16 * qb + li) * NC + C_QA + hq * 64 + 32 * s + 8 * kg);
        f32x4 O[4][2];
#pragma unroll
        for (int db = 0; db < 4; ++db) { O[db][0] = (f32x4){0.f, 0.f, 0.f, 0.f}; O[db][1] = O[db][0]; }
        const float sink2 = a.in[4][hq] * LOG2E;
        float mrow_[2] = {sink2, sink2}, lrow_[2] = {kg == 0 ? 1.f : 0.f, kg == 0 ? 1.f : 0.f};
        for (int ch = 0; ch < 10; ++ch) {
            int row0 = 0;
            if (ch > 0) { const int c = ch - 1 + qh; const int tok0 = tbase + 32 * c; if (tok0 < 0 || tok0 >= SEQ) continue; row0 = 32 + 32 * c; }
            bf16x8 Kf[2][2];
#pragma unroll
            for (int kb = 0; kb < 2; ++kb)
#pragma unroll
                for (int s = 0; s < 2; ++s) Kf[kb][s] = *(LAS const bf16x8*)(Ks + kvoff(row0 + 16 * kb + li, 4 * s + kg));
            f32x4 S[2][2];
#pragma unroll
            for (int kb = 0; kb < 2; ++kb)
#pragma unroll
                for (int qb = 0; qb < 2; ++qb) {
                    f32x4 z = {0.f, 0.f, 0.f, 0.f};
                    z = __builtin_amdgcn_mfma_f32_16x16x32_bf16(Kf[kb][0], Qf[qb][0], z, 0, 0, 0);
                    S[kb][qb] = __builtin_amdgcn_mfma_f32_16x16x32_bf16(Kf[kb][1], Qf[qb][1], z, 0, 0, 0);
                }
            if (ch == 0 || ch == 1 || ch == 9) {
#pragma unroll
                for (int kb = 0; kb < 2; ++kb)
#pragma unroll
                    for (int qb = 0; qb < 2; ++qb)
#pragma unroll
                        for (int j = 0; j < 4; ++j) { const int kk = 16 * kb + 4 * kg + j, qi = 16 * qb + li;
                            const bool ok = ch == 0 ? (kb == 0) : (ch == 1 ? kk >= qi : kk <= qi);
                            S[kb][qb][j] = ok ? S[kb][qb][j] : NEG_BIG; }
            }
            bf16x8 Pf[2];
#pragma unroll
            for (int qb = 0; qb < 2; ++qb) {
                float mx = fmaxf(fmaxf(fmaxf(S[0][qb][0], S[0][qb][1]), fmaxf(S[0][qb][2], S[0][qb][3])), fmaxf(fmaxf(S[1][qb][0], S[1][qb][1]), fmaxf(S[1][qb][2], S[1][qb][3])));
                mx = fmaxf(mx, __shfl_xor(mx, 16)); mx = fmaxf(mx, __shfl_xor(mx, 32));
                const float mnew = fmaxf(mrow_[qb], mx), alpha = ex2(mrow_[qb] - mnew); mrow_[qb] = mnew;
                float ls = 0.f;
#pragma unroll
                for (int kb = 0; kb < 2; ++kb)
#pragma unroll
                    for (int j = 0; j < 4; ++j) { const float p = ex2(S[kb][qb][j] - mnew); S[kb][qb][j] = p; ls += p; }
                lrow_[qb] = lrow_[qb] * alpha + ls;
#pragma unroll
                for (int db = 0; db < 4; ++db) O[db][qb] = O[db][qb] * alpha;
                Pf[qb] = pack_p(S[0][qb], S[1][qb]);
            }
#pragma unroll
            for (int db = 0; db < 4; ++db) {
                const bf16x8 Vf = vfrag(Vs, row0 + 4 * kg + qp, db, pp);
                O[db][0] = __builtin_amdgcn_mfma_f32_16x16x32_bf16(Vf, Pf[0], O[db][0], 0, 0, 0);
                O[db][1] = __builtin_amdgcn_mfma_f32_16x16x32_bf16(Vf, Pf[1], O[db][1], 0, 0, 0);
            }
        }
#pragma unroll
        for (int qb = 0; qb < 2; ++qb) {
            float l = lrow_[qb]; l += __shfl_xor(l, 16); l += __shfl_xor(l, 32);
            const float inv = 1.f / l;
            const size_t orow = (size_t)(b * SEQ + tq0 + 16 * qb + li);
#pragma unroll
            for (int db = 0; db < 4; ++db) { const int dcol = hq * 64 + 16 * db + 4 * kg;
                const v2u zz = *(const v2u*)(PROJ + orow * NC + C_ZA + dcol);
                const float o0 = O[db][qb][0] * inv * silu_(pg8::bfl(zz.x)), o1 = O[db][qb][1] * inv * silu_(pg8::bfh(zz.x)), o2 = O[db][qb][2] * inv * silu_(pg8::bfl(zz.y)), o3 = O[db][qb][3] * inv * silu_(pg8::bfh(zz.y));
                v2u w; w.x = pg8::cvt_pk_bf16(o0, o1); w.y = pg8::cvt_pk_bf16(o2, o3);
                *(v2u*)(OAB + orow * 512 + dcol) = w; }
        }
    }
}

__device__ __forceinline__ void attn_b_phase(const Args& a, LAS unsigned char* lds, int tid, int wave, int lane, int G) {
    const bf16* PROJ = (const bf16*)(a.ws + WS_PROJ);
    bf16* OAB = (bf16*)(a.ws + WS_XN);
    constexpr int KROWS = 608;
    LAS unsigned char* Ks = lds; LAS unsigned char* Vs = lds + KROWS * 128; LAS float* biasL = (LAS float*)(lds + 2 * KROWS * 128);
    const int li = lane & 15, kg = lane >> 4, qp = li >> 2, pp = li & 3;
    __syncthreads();
    if (tid < 128) { const v4u z = {0u, 0u, 0u, 0u}; *(LAS v4u*)(Ks + 16 * 128 + tid * 16) = z; *(LAS v4u*)(Vs + 16 * 128 + tid * 16) = z; }
    for (int item = blockIdx.x; item < 1024; item += G) {
        const int rp = item & 63, h = (item >> 6) & 7, b = item >> 9, r0 = 2 * rp;
        const int rs0 = r0 - 4 < 0 ? 0 : (r0 - 4 > 120 ? 120 : r0 - 4);
        __syncthreads();
        {
            if (tid < 480) { const int dr = tid >> 5, dc = tid & 31; biasL[tid] = dc < 31 ? a.in[5][(h * 15 + dr) * 31 + dc] * LOG2E : 0.f; }
            v4u mv = {0u, 0u, 0u, 0u}; const int mw = tid >> 7, mp = tid & 127, mrow = mp >> 3, mc = mp & 7;
            if (tid < 256) mv = *(const v4u*)(PROJ + (size_t)(M + mrow) * NC + (mw ? C_VB : C_KB) + h * 64 + mc * 8);
            if (tid < 256) *(LAS v4u*)((mw ? Vs : Ks) + kvoff(mrow, mc)) = mv;
#pragma unroll
            for (int half = 0; half < 3; ++half) {
                v4u kv[3], vv[3];
#pragma unroll
                for (int i = 0; i < 3; ++i) { const int p = tid + 512 * (3 * half + i), rr = p >> 3, c16 = p & 7, grow = rs0 + (rr >> 6);
                    if (grow < 128) { const bf16* src = PROJ + (size_t)(b * SEQ + grow * 64 + (rr & 63)) * NC + h * 64 + c16 * 8; kv[i] = *(const v4u*)(src + C_KB); vv[i] = *(const v4u*)(src + C_VB); }
                    else { kv[i] = (v4u){0u, 0u, 0u, 0u}; vv[i] = kv[i]; } }
#pragma unroll
                for (int i = 0; i < 3; ++i) { const int p = tid + 512 * (3 * half + i), rr = p >> 3, c16 = p & 7; const int o = kvoff(32 + rr, c16);
                    *(LAS v4u*)(Ks + o) = kv[i]; *(LAS v4u*)(Vs + o) = vv[i]; }
            }
        }
        __syncthreads();
        const int rsel = wave >> 2, qb = wave & 3, r = r0 + rsel;
        const int rs = r - 4 < 0 ? 0 : (r - 4 > 120 ? 120 : r - 4), roff = rs - rs0;
        const int cst = qb == 0 ? 0 : (qb == 1 ? 8 : (qb == 2 ? 24 : 32));
        const int c = 16 * qb + li, csq = c - 8 < 0 ? 0 : (c - 8 > 48 ? 48 : c - 8);
        const size_t qrow = (size_t)(b * SEQ + r * 64 + c);
        bf16x8 Qf[2];
#pragma unroll
        for (int s = 0; s < 2; ++s) Qf[s] = *(const bf16x8*)(PROJ + qrow * NC + C_QB + h * 64 + 32 * s + 8 * kg);
        f32x4 O[4];
#pragma unroll
        for (int db = 0; db < 4; ++db) O[db] = (f32x4){0.f, 0.f, 0.f, 0.f};
        float mrow_ = NEG_BIG, lrow_ = 0.f;
        for (int ch = 0; ch < 9; ++ch) {
            const int row0 = ch == 0 ? 0 : 32 + 64 * (roff + ch - 1) + cst;
            bf16x8 Kf[2][2];
#pragma unroll
            for (int kb = 0; kb < 2; ++kb)
#pragma unroll
                for (int s = 0; s < 2; ++s) Kf[kb][s] = *(LAS const bf16x8*)(Ks + kvoff(row0 + 16 * kb + li, 4 * s + kg));
            f32x4 S[2];
#pragma unroll
            for (int kb = 0; kb < 2; ++kb) {
                f32x4 z = {0.f, 0.f, 0.f, 0.f};
                z = __builtin_amdgcn_mfma_f32_16x16x32_bf16(Kf[kb][0], Qf[0], z, 0, 0, 0);
                S[kb] = __builtin_amdgcn_mfma_f32_16x16x32_bf16(Kf[kb][1], Qf[1], z, 0, 0, 0);
            }
            if (ch == 0) { S[1] = (f32x4){NEG_BIG, NEG_BIG, NEG_BIG, NEG_BIG}; }
            else {
                const int dr = rs + (ch - 1) - r + 7;
#pragma unroll
                for (int kb = 0; kb < 2; ++kb)
#pragma unroll
                    for (int j = 0; j < 4; ++j) { const int kc = cst + 16 * kb + 4 * kg + j; const bool ok = kc >= csq && kc <= csq + 15;
                        int dc = kc - c + 15; dc = dc < 0 ? 0 : (dc > 31 ? 31 : dc);
                        const float bv = biasL[dr * 32 + dc];
                        S[kb][j] = ok ? S[kb][j] + bv : NEG_BIG; }
            }
            float mx = fmaxf(fmaxf(fmaxf(S[0][0], S[0][1]), fmaxf(S[0][2], S[0][3])), fmaxf(fmaxf(S[1][0], S[1][1]), fmaxf(S[1][2], S[1][3])));
            mx = fmaxf(mx, __shfl_xor(mx, 16)); mx = fmaxf(mx, __shfl_xor(mx, 32));
            const float mnew = fmaxf(mrow_, mx), alpha = ex2(mrow_ - mnew); mrow_ = mnew;
            float ls = 0.f;
#pragma unroll
            for (int kb = 0; kb < 2; ++kb)
#pragma unroll
                for (int j = 0; j < 4; ++j) { const float p = ex2(S[kb][j] - mnew); S[kb][j] = p; ls += p; }
            lrow_ = lrow_ * alpha + ls;
            const bf16x8 Pf = pack_p(S[0], S[1]);
#pragma unroll
            for (int db = 0; db < 4; ++db) {
                const bf16x8 Vf = vfrag(Vs, row0 + 4 * kg + qp, db, pp);
                O[db] = __builtin_amdgcn_mfma_f32_16x16x32_bf16(Vf, Pf, O[db] * alpha, 0, 0, 0);
            }
        }
        float l = lrow_; l += __shfl_xor(l, 16); l += __shfl_xor(l, 32);
        const float inv = 1.f / l;
#pragma unroll
        for (int db = 0; db < 4; ++db) { const int dcol = h * 64 + 16 * db + 4 * kg;
            const v2u zz = *(const v2u*)(PROJ + qrow * NC + C_ZB + dcol);
            const float o0 = O[db][0] * inv * silu_(pg8::bfl(zz.x)), o1 = O[db][1] * inv * silu_(pg8::bfh(zz.x)), o2 = O[db][2] * inv * silu_(pg8::bfl(zz.y)), o3 = O[db][3] * inv * silu_(pg8::bfh(zz.y));
            v2u w; w.x = pg8::cvt_pk_bf16(o0, o1); w.y = pg8::cvt_pk_bf16(o2, o3);
            *(v2u*)(OAB + ((size_t)M + qrow) * 512 + dcol) = w; }
    }
}

__device__ __forceinline__ void final_norm_phase(const Args& a, int wave, int lane, int G) {
    const float* ssq = (const float*)(a.ws + WS_SSQ);
    const f32x4* gp = (const f32x4*)a.in[9] + lane;
    const int gw = blockIdx.x * NWAVES + wave, NGW = G * NWAVES;
    for (int m = gw; m < M; m += NGW) {
        float s = ssq[(size_t)m * 16 + (lane & 15)];
        s += __shfl_xor(s, 1); s += __shfl_xor(s, 2); s += __shfl_xor(s, 4); s += __shfl_xor(s, 8);
        const float rs = 1.f / sqrtf(s * (1.f / D) + RMS_EPS);
        f32x4* o = (f32x4*)(a.out + (size_t)m * D) + lane;
#pragma unroll
        for (int j = 0; j < 4; ++j) o[64 * j] = o[64 * j] * rs * gp[64 * j];
    }
}

__global__ void __launch_bounds__(NWAVES * 64, 2) fwd_kernel(Args a) {
    extern __shared__ __attribute__((aligned(16))) unsigned char lds_raw[];
    LAS unsigned char* lds = (LAS unsigned char*)lds_raw;
    cg::grid_group grid = cg::this_grid();
    const int tid = threadIdx.x, lane = tid & 63, wave = __builtin_amdgcn_readfirstlane(tid >> 6), G = gridDim.x;
    unsigned char* ws = a.ws;
    p0_prologue(a, lds, wave, lane, G);
    grid.sync();
    { pg8::Gemm g{(const pg8::bf16_t*)(ws + WS_XN), (const pg8::bf16_t*)(ws + WS_WIN), MP, NC, D};
      pg8::ProjOrder S; S.init(G, (int)blockIdx.x);
      pg8::EpiProj E{(pg8::bf16_t*)(ws + WS_PROJ), (const float*)(ws + WS_ROPE)};
      pg8::gemm_phase<pg8::EpiProj, pg8::ProjOrder, true, true>(lds, g, S, E); }
    grid.sync();
#ifndef NAIVE_A
    attn_a_phase(a, lds, tid, wave, lane, G);
#else
    naive_attn_phase(a, lds, wave, lane, G, 0, 1);
#endif
#ifndef NAIVE_B
    attn_b_phase(a, lds, tid, wave, lane, G);
#else
    __syncthreads();
    naive_attn_phase(a, lds, wave, lane, G, 1, 2);
#endif
    grid.sync();
    { pg8::Gemm g{(const pg8::bf16_t*)(ws + WS_XN), (const pg8::bf16_t*)(ws + WS_WP), 2 * M, 2048, 512};
      pg8::MergeOrder S{G, (int)blockIdx.x};
      pg8::EpiMerge E{(const pg8::bf16_t*)(ws + WS_PROJ), (pg8::bf16_t*)(ws + WS_MG)};
      pg8::gemm_phase<pg8::EpiMerge, pg8::MergeOrder, true, true>(lds, g, S, E); }
    grid.sync();
    { pg8::Gemm g{(const pg8::bf16_t*)(ws + WS_MG), (const pg8::bf16_t*)(ws + WS_WO), M, D, D};
      pg8::StaticOrder S; S.init(M, D, G, (int)blockIdx.x);
      pg8::EpiOut E{a.in[0], a.out, (float*)(ws + WS_SSQ)};
      pg8::gemm_phase<pg8::EpiOut, pg8::StaticOrder, false, true>(lds, g, S, E); }
    grid.sync();
    final_norm_phase(a, wave, lane, G);
}

extern "C" void kernel_launch(void* const* d_in, const int* in_sizes, int n_in, void* d_out, int out_size, void* d_ws, size_t ws_size, hipStream_t stream) {
    static int grid = 0;
    if (grid == 0) {
        if (n_in != 10 || in_sizes[0] != M * D || out_size != M * D || ws_size < 256 * MiB) { fprintf(stderr, "kernel_launch: unexpected shapes (n_in %d, in0 %d, out %d, ws %zu)\n", n_in, n_in > 0 ? in_sizes[0] : -1, out_size, ws_size); grid = -1; return; }
        int dev = 0, cus = 0, per_cu = 0;
        (void)hipGetDevice(&dev); (void)hipDeviceGetAttribute(&cus, hipDeviceAttributeMultiprocessorCount, dev);
        if (hipFuncSetAttribute((const void*)fwd_kernel, hipFuncAttributeMaxDynamicSharedMemorySize, LDS_BYTES) != hipSuccess) { fprintf(stderr, "kernel_launch: hipFuncSetAttribute failed\n"); grid = -1; return; }
        if (hipOccupancyMaxActiveBlocksPerMultiprocessor(&per_cu, (const void*)fwd_kernel, NWAVES * 64, LDS_BYTES) != hipSuccess || per_cu < 1) { fprintf(stderr, "kernel_launch: occupancy query says %d\n", per_cu); per_cu = 1; }
        (void)hipGetLastError();
        grid = cus;
    }
    if (grid < 0) return;
    Args a{};
    for (int i = 0; i < 10; ++i) a.in[i] = (const float*)d_in[i];
    a.out = (float*)d_out; a.ws = (unsigned char*)d_ws;
    void* args[] = {&a};
    hipError_t e = hipLaunchCooperativeKernel((const void*)fwd_kernel, dim3(grid), dim3(NWAVES * 64), args, LDS_BYTES, stream);
    if (e != hipSuccess) fprintf(stderr, "cooperative launch failed: %s (grid %d)\n", hipGetErrorString(e), grid);
}
```

```cpp
#include <hip/hip_runtime.h>
#include <hip/hip_cooperative_groups.h>
#include <cstdio>
#include <cstdint>
namespace cg = cooperative_groups;
#ifndef REP_P1S
#define REP_P1S 1
#endif
#ifndef REP_P3S
#define REP_P3S 1
#endif
namespace pg8 {
#define PG8_LAS __attribute__((address_space(3)))
typedef unsigned short bf16_t;
typedef short bf16x8 __attribute__((ext_vector_type(8)));
typedef float f32x4 __attribute__((ext_vector_type(4)));
typedef unsigned u32x4 __attribute__((ext_vector_type(4)));
constexpr int BM = 256, BK = 64, HALF = 128, HTB = HALF * BK * 2  , STAGE_BYTES = 8 * HTB, NXCD = 8, WGM = 8;

__host__ __device__ __forceinline__ int lds_byte(int r, int c) { const int st = (r >> 4) * 2 + (c >> 5), rr = r & 15, cc = c & 31, ob = rr * 64 + cc * 2; return st * 1024 + (ob ^ (((ob >> 9) & 1) << 5)); }
__host__ __device__ __forceinline__ void stage_rc(int b, int& R, int& C) { const int st = b / 1024, sb = b % 1024, swz = sb ^ (((sb >> 9) & 1) << 5); R = (st >> 1) * 16 + swz / 64; C = (st & 1) * 32 + (swz % 64) / 2; }
__host__ __device__ __forceinline__ int perm32(int rho) { const int n = rho >> 4, i = rho & 15; return 8 * (i >> 2) + 4 * n + (i & 3); }

struct Unit { int pm, pn; };
struct Gemm { const bf16_t* A; const bf16_t* Bt; int M, N, K; };

struct StaticOrder {
    int nM, nN, nwg, G, c;
    __host__ __device__ void init(int M, int N, int G_, int c_) { nM = M / BM; nN = N / BM; nwg = nM * nN; G = G_; c = c_; }
    __host__ __device__ bool next(int i, Unit& u) const {
        const long L = (long)i * G + c; if (L >= nwg) return false;
        int wgid = (int)L; { const int q = nwg / NXCD, r = nwg % NXCD, xcd = wgid % NXCD, off = wgid / NXCD; wgid = (xcd < r ? xcd * (q + 1) : r * (q + 1) + (xcd - r) * q) + off; }
        const int nig = WGM * nN, gid = wgid / nig, fm = gid * WGM, gsz = (nM - fm) < WGM ? (nM - fm) : WGM;
        u.pm = fm + ((wgid % nig) % gsz); u.pn = (wgid % nig) / gsz; return true;
    }
    __device__ __forceinline__ void a_ready(const Unit&) const {}
    __device__ __forceinline__ void done(const Unit&) const {}
};
__device__ __forceinline__ unsigned cvt_pk_bf16(float lo, float hi) { unsigned r; asm volatile("v_cvt_pk_bf16_f32 %0, %1, %2" : "=v"(r) : "v"(lo), "v"(hi)); return r; }
constexpr int PROJ_LD = 5376;
constexpr float QSCALE = 0.18033688011112042f;
__device__ __forceinline__ float bfl(unsigned u) { return __builtin_bit_cast(float, u << 16); }
__device__ __forceinline__ float bfh(unsigned u) { return __builtin_bit_cast(float, u & 0xffff0000u); }
__device__ __forceinline__ float sigmoidf_(float x) { return 1.f / (1.f + __expf(-x)); }

struct EpiProj {
    static constexpr bool PERM = true, AFTER_DRAIN = false;
    bf16_t* O; const float* rope;
    __device__ __forceinline__ void operator()(const f32x4 (&acc)[2][2][4][2], const Unit& u, int wr, int wc, int fr, int fq) const {
        const int pn = u.pn;
        const bool rope_t = (pn <= 2) && ((wc & 1) == 0);
        const float sc = (pn <= 1 || pn == 5 || pn == 6) ? QSCALE : 1.f;
        const int row0 = u.pm * BM + wr * 64 + fr, col0 = pn * BM + wc * 32 + 8 * fq;
#pragma unroll
        for (int ai = 0; ai < 2; ++ai)
#pragma unroll
            for (int m = 0; m < 4; ++m) {
                const int row = row0 + ai * HALF + m * 16;
                f32x4 c0 = {1.f, 1.f, 1.f, 1.f}, c1 = c0, s0 = {0.f, 0.f, 0.f, 0.f}, s1 = s0;
                if (rope_t) { const int pos = row < 16384 ? (row & 8191) + 16 : row - 16384; const f32x4* rp = (const f32x4*)(rope + (size_t)pos * 16);
                    c0 = rp[0]; c1 = rp[1]; s0 = rp[2]; s1 = rp[3]; }
                bf16_t* rowp = O + (size_t)row * PROJ_LD + col0;
#pragma unroll
                for (int bj = 0; bj < 2; ++bj) {
                    f32x4 v0 = acc[ai][bj][m][0], v1 = acc[ai][bj][m][1];
                    if (rope_t && (pn < 2 || bj == 0)) {
                        f32x4 p0, p1;
#pragma unroll
                        for (int i = 0; i < 4; ++i) { p0[i] = __shfl_xor(v0[i], 16); p1[i] = __shfl_xor(v1[i], 16); }
                        if (fq == 0) { v0 = v0 * c0 - p0 * s0; v1 = v1 * c1 - p1 * s1; }
                        else if (fq == 1) { v0 = v0 * c0 + p0 * s0; v1 = v1 * c1 + p1 * s1; }
                    }
                    v0 = v0 * sc; v1 = v1 * sc;
                    u32x4 w; w.x = cvt_pk_bf16(v0[0], v0[1]); w.y = cvt_pk_bf16(v0[2], v0[3]); w.z = cvt_pk_bf16(v1[0], v1[1]); w.w = cvt_pk_bf16(v1[2], v1[3]);
                    *(u32x4*)(rowp + bj * HALF) = w;
                }
            }
    }
};

struct EpiMerge {
    static constexpr bool PERM = true, AFTER_DRAIN = false;
    const bf16_t* proj; bf16_t* merged;
    __device__ __forceinline__ void operator()(const f32x4 (&acc)[2][2][4][2], const Unit& u, int wr, int wc, int fr, int fq) const {
        const int part = u.pn >= 4 ? 1 : 0, pm = u.pm - 64 * part, pn = u.pn - 4 * part;
        const int row0 = pm * BM + wr * 64 + fr, col0 = pn * BM + wc * 32 + 8 * fq;
        const int gcol = (part ? 4352 : 3328) + col0;
#pragma unroll
        for (int ai = 0; ai < 2; ++ai)
#pragma unroll
            for (int m = 0; m < 4; ++m) {
                const int row = row0 + ai * HALF + m * 16;
#pragma unroll
                for (int bj = 0; bj < 2; ++bj) {
                    const u32x4 g = *(const u32x4*)(proj + (size_t)row * PROJ_LD + gcol + bj * HALF);
                    bf16_t* mp = merged + (size_t)row * 1024 + col0 + bj * HALF;
                    const f32x4 a0 = acc[ai][bj][m][0], a1 = acc[ai][bj][m][1];
                    float v[8];
                    v[0] = sigmoidf_(bfl(g.x)) * a0[0]; v[1] = sigmoidf_(bfh(g.x)) * a0[1]; v[2] = sigmoidf_(bfl(g.y)) * a0[2]; v[3] = sigmoidf_(bfh(g.y)) * a0[3];
                    v[4] = sigmoidf_(bfl(g.z)) * a1[0]; v[5] = sigmoidf_(bfh(g.z)) * a1[1]; v[6] = sigmoidf_(bfl(g.w)) * a1[2]; v[7] = sigmoidf_(bfh(g.w)) * a1[3];
                    if (part) { const u32x4 p = *(const u32x4*)mp;
                        v[0] += bfl(p.x); v[1] += bfh(p.x); v[2] += bfl(p.y); v[3] += bfh(p.y); v[4] += bfl(p.z); v[5] += bfh(p.z); v[6] += bfl(p.w); v[7] += bfh(p.w); }
                    u32x4 w; w.x = cvt_pk_bf16(v[0], v[1]); w.y = cvt_pk_bf16(v[2], v[3]); w.z = cvt_pk_bf16(v[4], v[5]); w.w = cvt_pk_bf16(v[6], v[7]);
                    *(u32x4*)mp = w;
                }
            }
    }
};

struct EpiOut {
    static constexpr bool PERM = true, AFTER_DRAIN = false;
    const float* x; float* out; float* ssq;
    __device__ __forceinline__ void operator()(const f32x4 (&acc)[2][2][4][2], const Unit& u, int wr, int wc, int fr, int fq) const {
        const int row0 = u.pm * BM + wr * 64 + fr, col0 = u.pn * BM + wc * 32 + 8 * fq;
#pragma unroll
        for (int ai = 0; ai < 2; ++ai)
#pragma unroll
            for (int m = 0; m < 4; ++m) {
                const int row = row0 + ai * HALF + m * 16; float s = 0.f;
#pragma unroll
                for (int bj = 0; bj < 2; ++bj) {
                    const size_t o = (size_t)row * 1024 + col0 + bj * HALF;
                    const f32x4 h0 = *(const f32x4*)(x + o) + acc[ai][bj][m][0], h1 = *(const f32x4*)(x + o + 4) + acc[ai][bj][m][1];
                    *(f32x4*)(out + o) = h0; *(f32x4*)(out + o + 4) = h1;
                    s += (h0[0] * h0[0] + h0[1] * h0[1]) + (h0[2] * h0[2] + h0[3] * h0[3]) + (h1[0] * h1[0] + h1[1] * h1[1]) + (h1[2] * h1[2] + h1[3] * h1[3]);
                }
                s += __shfl_xor(s, 16); s += __shfl_xor(s, 32);
                if (fq == 0) ssq[(size_t)row * 16 + u.pn * 4 + wc] = s;
            }
    }
};

struct ProjOrder {
    StaticOrder so; int G, c;
    __device__ void init(int G_, int c_) { so.init(16384, 5376, G_, c_); G = G_; c = c_; }
    __device__ bool next(int i, Unit& u) const {
        long L = (long)i * G + c;
        if (L >= (long)1349 * REP_P1S) return false;
        L %= 1349;
        if (L < 1344) { StaticOrder t = so; t.c = (int)(L % G); return t.next((int)(L / G), u); }
        const int e = (int)(L - 1344);
        u.pm = 64; u.pn = e == 0 ? 2 : 6 + e; return true;
    }
    __device__ __forceinline__ void a_ready(const Unit&) const {}
    __device__ __forceinline__ void done(const Unit&) const {}
};
struct MergeOrder {
    int G, c;
    __device__ bool next(int i, Unit& u) const {
        int T = c + (i >> 1) * G; if (T >= 256 * REP_P3S) return false; T &= 255;
        const int part = i & 1, x = T & 7, o = T >> 3;
        u.pm = 8 * x + (o & 7) + 64 * part; u.pn = (o >> 3) + 4 * part; return true;
    }
    __device__ __forceinline__ void a_ready(const Unit&) const {}
    __device__ __forceinline__ void done(const Unit&) const {}
};
template <class Epi, class Sched, bool ALIGN_EPI = false, bool SP2 = false>
__device__ __forceinline__ void gemm_phase(PG8_LAS unsigned char* lds, const Gemm g, const Sched& S, const Epi& E) {
    const int tid = threadIdx.x, wid = __builtin_amdgcn_readfirstlane(tid >> 6), lane = tid & 63, wr = wid >> 2, wc = wid & 3, fr = lane & 15, fq = lane >> 4;
    const int K = g.K, nt = K / BK;
    unsigned voffA[2], voffB[2];
#pragma unroll
    for (int i = 0; i < 2; ++i) { int R, C; stage_rc(tid * 16 + i * 8192, R, C); const int Rb = Epi::PERM ? ((R & ~31) + perm32(R & 31)) : R;
        voffA[i] = (unsigned)(R * K + C) * 2u; voffB[i] = (unsigned)(Rb * K + C) * 2u; }
    const size_t kstep = (size_t)(BK * 2);
    const size_t hstep = (size_t)HALF * K * 2;
    const size_t tstep = 2 * hstep;
    const unsigned ldsw = (unsigned)wid * 1024u;
    const int aoff = lds_byte(wr * 64 + fr, fq * 8), boff = lds_byte(wc * 32 + fr, fq * 8);
#define PG8_SA(b, h) (((b) * 2 + (h)) * HTB)
#define PG8_SB(b, h) ((4 + (b) * 2 + (h)) * HTB)
#define PG8_STAGE(bufoff, gbase, voff) do { _Pragma("unroll") for (int _i = 0; _i < 2; ++_i) \
        __builtin_amdgcn_global_load_lds((const unsigned*)((const char*)(gbase) + (voff)[_i]), (PG8_LAS unsigned*)(lds + (bufoff) + ldsw + _i * 8192), 16, 0, 0); } while (0)
#define PG8_LDA(dst, b, h) do { _Pragma("unroll") for (int m = 0; m < 4; ++m) _Pragma("unroll") for (int k = 0; k < 2; ++k) dst[m][k] = *(const PG8_LAS bf16x8*)(lds + PG8_SA(b, h) + aoff + m * 2048 + k * 1024); } while (0)
#define PG8_LDB(dst, b, h) do { _Pragma("unroll") for (int n = 0; n < 2; ++n) _Pragma("unroll") for (int k = 0; k < 2; ++k) dst[n][k] = *(const PG8_LAS bf16x8*)(lds + PG8_SB(b, h) + boff + n * 2048 + k * 1024); } while (0)
#define PG8_MMA(ai, bj, At, Bt) do { __builtin_amdgcn_s_setprio(1); _Pragma("unroll") for (int m = 0; m < 4; ++m) _Pragma("unroll") for (int n = 0; n < 2; ++n) _Pragma("unroll") for (int k = 0; k < 2; ++k) \
        acc[ai][bj][m][n] = __builtin_amdgcn_mfma_f32_16x16x32_bf16(Bt[n][k], At[m][k], acc[ai][bj][m][n], 0, 0, 0); __builtin_amdgcn_s_setprio(0); } while (0)
#define PG8_WAIT_V(n) asm volatile("s_waitcnt vmcnt(" #n ")" ::: "memory")
#define PG8_WAIT_L(n) asm volatile("s_waitcnt lgkmcnt(" #n ")" ::: "memory")
#define PG8_BAR __builtin_amdgcn_s_barrier()
#define PG8_SCHED __builtin_amdgcn_sched_barrier(0)
    Unit cur, nxt; int ui = 0;
    if (!S.next(0, cur)) return;
    f32x4 acc[2][2][4][2];
#pragma unroll
    for (int a = 0; a < 2; ++a)
#pragma unroll
        for (int b = 0; b < 2; ++b)
#pragma unroll
            for (int m = 0; m < 4; ++m)
#pragma unroll
                for (int n = 0; n < 2; ++n) acc[a][b][m][n] = (f32x4){0.f, 0.f, 0.f, 0.f};
    bf16x8 At[4][2], B0[2][2], B1[2][2];
    const char* cA = (const char*)g.A + (size_t)cur.pm * tstep; const char* cB = (const char*)g.Bt + (size_t)cur.pn * tstep;
    S.a_ready(cur);
    if constexpr (SP2) {
        PG8_STAGE(PG8_SB(0, 0), cB, voffB); PG8_STAGE(PG8_SB(0, 1), cB + hstep, voffB); PG8_STAGE(PG8_SA(0, 0), cA, voffA); PG8_STAGE(PG8_SA(0, 1), cA + hstep, voffA);
        if (wr == 1) PG8_BAR;
        PG8_WAIT_V(2); PG8_BAR;
        PG8_STAGE(PG8_SB(1, 0), cB + kstep, voffB); PG8_STAGE(PG8_SA(1, 0), cA + kstep, voffA); PG8_STAGE(PG8_SB(1, 1), cB + hstep + kstep, voffB);
        PG8_WAIT_V(6); PG8_BAR;
    } else {
        PG8_STAGE(PG8_SB(0, 0), cB, voffB); PG8_STAGE(PG8_SA(0, 0), cA, voffA); PG8_STAGE(PG8_SB(0, 1), cB + hstep, voffB); PG8_STAGE(PG8_SA(0, 1), cA + hstep, voffA);
        if (wr == 1) PG8_BAR;
        PG8_WAIT_V(4); PG8_BAR;
        PG8_STAGE(PG8_SB(1, 0), cB + kstep, voffB); PG8_STAGE(PG8_SA(1, 0), cA + kstep, voffA); PG8_STAGE(PG8_SB(1, 1), cB + hstep + kstep, voffB);
        PG8_WAIT_V(6); PG8_BAR;
    }
    for (;;) {
        const bool has_next = S.next(ui + 1, nxt);
        const char* nA = has_next ? (const char*)g.A + (size_t)nxt.pm * tstep : cA; const char* nB = has_next ? (const char*)g.Bt + (size_t)nxt.pn * tstep : cB;
        for (int t = 0; t < nt; t += 2) {
            const bool last = (t == nt - 2);
            const char* a1 = cA + (size_t)(t + 1) * kstep;
            const char* a2 = last ? nA : cA + (size_t)(t + 2) * kstep; const char* b2 = last ? nB : cB + (size_t)(t + 2) * kstep;
            const char* a3 = a2 + kstep; const char* b3 = b2 + kstep;
            if (last && has_next) S.a_ready(nxt);
            if constexpr (SP2) {
            PG8_LDB(B0, 0, 0); PG8_LDB(B1, 0, 1); PG8_SCHED; PG8_LDA(At, 0, 0); PG8_STAGE(PG8_SA(1, 1), a1 + hstep, voffA);
            PG8_WAIT_V(8); PG8_WAIT_L(0); PG8_BAR; PG8_MMA(0, 0, At, B0); PG8_MMA(0, 1, At, B1); PG8_BAR; PG8_SCHED;
            PG8_LDA(At, 0, 1); PG8_STAGE(PG8_SB(0, 0), b2, voffB); PG8_STAGE(PG8_SB(0, 1), b2 + hstep, voffB); PG8_STAGE(PG8_SA(0, 0), a2, voffA);
            PG8_WAIT_V(8); PG8_WAIT_L(0); PG8_BAR; PG8_MMA(1, 0, At, B0); PG8_MMA(1, 1, At, B1); PG8_BAR; PG8_SCHED;
            PG8_LDB(B0, 1, 0); PG8_LDB(B1, 1, 1); PG8_SCHED; PG8_LDA(At, 1, 0); PG8_STAGE(PG8_SA(0, 1), a2 + hstep, voffA);
            PG8_WAIT_V(8); PG8_WAIT_L(0); PG8_BAR; PG8_MMA(0, 0, At, B0); PG8_MMA(0, 1, At, B1); PG8_BAR; PG8_SCHED;
            PG8_LDA(At, 1, 1); PG8_STAGE(PG8_SB(1, 0), b3, voffB); PG8_STAGE(PG8_SB(1, 1), b3 + hstep, voffB); PG8_STAGE(PG8_SA(1, 0), a3, voffA);
            PG8_WAIT_V(8); PG8_WAIT_L(0); PG8_BAR; PG8_MMA(1, 0, At, B0); PG8_MMA(1, 1, At, B1); PG8_BAR; PG8_SCHED;
            } else {
            PG8_LDB(B0, 0, 0); PG8_SCHED; PG8_LDA(At, 0, 0); PG8_STAGE(PG8_SA(1, 1), a1 + hstep, voffA);
            PG8_WAIT_L(8); PG8_BAR; PG8_WAIT_L(0); PG8_MMA(0, 0, At, B0); PG8_BAR; PG8_SCHED;
            PG8_LDB(B1, 0, 1); PG8_STAGE(PG8_SB(0, 0), b2, voffB);
            PG8_BAR; PG8_WAIT_L(0); PG8_MMA(0, 1, At, B1); PG8_BAR;
            PG8_LDA(At, 0, 1); PG8_STAGE(PG8_SA(0, 0), a2, voffA);
            PG8_BAR; PG8_WAIT_L(0); PG8_MMA(1, 0, At, B0); PG8_BAR; PG8_SCHED;
            PG8_STAGE(PG8_SB(0, 1), b2 + hstep, voffB);
            PG8_WAIT_V(6); PG8_BAR; PG8_MMA(1, 1, At, B1); PG8_BAR;
            PG8_LDB(B0, 1, 0); PG8_SCHED; PG8_LDA(At, 1, 0); PG8_STAGE(PG8_SA(0, 1), a2 + hstep, voffA);
            PG8_WAIT_L(8); PG8_BAR; PG8_WAIT_L(0); PG8_MMA(0, 0, At, B0); PG8_BAR; PG8_SCHED;
            PG8_LDB(B1, 1, 1); PG8_STAGE(PG8_SB(1, 0), b3, voffB);
            PG8_BAR; PG8_WAIT_L(0); PG8_MMA(0, 1, At, B1); PG8_BAR;
            PG8_LDA(At, 1, 1); PG8_STAGE(PG8_SA(1, 0), a3, voffA);
            PG8_BAR; PG8_WAIT_L(0); PG8_MMA(1, 0, At, B0); PG8_BAR; PG8_SCHED;
            PG8_STAGE(PG8_SB(1, 1), b3 + hstep, voffB);
            PG8_WAIT_V(6); PG8_BAR; PG8_MMA(1, 1, At, B1); PG8_BAR;
            }
        }
        if constexpr (ALIGN_EPI) { if (wr == 0) PG8_BAR; }
        if constexpr (!Epi::AFTER_DRAIN) { E(acc, cur, wr, wc, fr, fq); S.done(cur); }
        if (!has_next) break;
#pragma unroll
        for (int a = 0; a < 2; ++a)
#pragma unroll
            for (int b = 0; b < 2; ++b)
#pragma unroll
                for (int m = 0; m < 4; ++m)
#pragma unroll
                    for (int n = 0; n < 2; ++n) acc[a][b][m][n] = (f32x4){0.f, 0.f, 0.f, 0.f};
        cur = nxt; cA = nA; cB = nB; ++ui;
        if constexpr (ALIGN_EPI) { if (wr == 1) PG8_BAR; }
    }
    PG8_WAIT_V(0);
    if constexpr (!ALIGN_EPI) { if (wr == 0) PG8_BAR; }
    PG8_BAR;
    if constexpr (Epi::AFTER_DRAIN) { E.fused(acc, cur, wr, wc, fr, fq, lds, wid, lane); S.done(cur); }
#undef PG8_SA
#undef PG8_SB
#undef PG8_STAGE
#undef PG8_LDA
#undef PG8_LDB
#undef PG8_MMA
#undef PG8_WAIT_V
#undef PG8_WAIT_L
#undef PG8_BAR
#undef PG8_SCHED
}
}
#define GAS __attribute__((address_space(1)))
#define LAS __attribute__((address_space(3)))
typedef unsigned short bf16;
typedef unsigned v4u __attribute__((ext_vector_type(4)));
typedef unsigned v2u __attribute__((ext_vector_type(2)));
typedef float f32x4 __attribute__((ext_vector_type(4)));
typedef short bf16x8 __attribute__((ext_vector_type(8)));
constexpr int NWAVES = 8;
#ifndef REP_P0
#define REP_P0 1
#endif
#ifndef REP_P1
#define REP_P1 1
#endif
#ifndef REP_A
#define REP_A 1
#endif
#ifndef REP_B
#define REP_B 1
#endif
#ifndef REP_P3
#define REP_P3 1
#endif
#ifndef REP_P4
#define REP_P4 1
#endif
constexpr int M = 16384, D = 1024, NC = 5376, MP = 16640, SEQ = 8192, NMETA = 16, LPOS = SEQ + NMETA;
constexpr int C_QA = 0, C_KA = 512, C_VA = 640, C_ZA = 768, C_QB = 1280, C_KB = 1792, C_VB = 2304, C_ZB = 2816, C_GA = 3328, C_GB = 4352;
constexpr float RMS_EPS = 1e-6f, LOG2E = 1.4426950408889634f;
constexpr size_t MiB = 1u << 20;
constexpr size_t WS_WIN = 1 * MiB, WS_WP = 12 * MiB, WS_WO = 14 * MiB, WS_ROPE = 16 * MiB, WS_SSQ = 17 * MiB, WS_XN = 18 * MiB, WS_MG = 51 * MiB, WS_PROJ = 84 * MiB;
static_assert(WS_XN + (size_t)MP * D * 2 <= WS_MG && WS_MG + (size_t)M * D * 2 <= WS_PROJ && WS_PROJ + (size_t)MP * NC * 2 <= 256 * MiB, "ws map");
constexpr int LDS_BYTES = 163840 - 4096;
#define LDS_WAIT() asm volatile("s_waitcnt lgkmcnt(0)" ::: "memory")
__device__ __forceinline__ unsigned f2bf(float f) { unsigned u = __builtin_bit_cast(unsigned, f); return (u + 0x7fffu + ((u >> 16) & 1u)) >> 16; }
__device__ __forceinline__ unsigned pk2(float lo, float hi) { return f2bf(lo) | (f2bf(hi) << 16); }
__device__ __forceinline__ float bf2f(unsigned short h) { return __builtin_bit_cast(float, (unsigned)h << 16); }
__device__ __forceinline__ float wave_sum(float v) {
#pragma unroll
    for (int o = 1; o < 64; o <<= 1) v += __shfl_xor(v, o);
    return v;
}
__device__ __forceinline__ float wave_max(float v) {
#pragma unroll
    for (int o = 1; o < 64; o <<= 1) v = fmaxf(v, __shfl_xor(v, o));
    return v;
}

#define XB_TMO      128
#define XB_XCNT(j)  (256  + 64 * (j))
#define XB_XSUB(j)  (1280 + 64 * (j))
#define XB_XGEN(j)  (2304 + 64 * (j))
#define XB_TOP      3328
#define XB_TOPGEN   3392
#define XCD_BAR_WORDS 3456
#define XB_SPIN_CAP (1u << 18)

__device__ __forceinline__ unsigned xb_ld(unsigned* p)              { return __hip_atomic_load(p, __ATOMIC_RELAXED, __HIP_MEMORY_SCOPE_AGENT); }
__device__ __forceinline__ unsigned xb_add(unsigned* p, unsigned v) { return __hip_atomic_fetch_add(p, v, __ATOMIC_RELAXED, __HIP_MEMORY_SCOPE_AGENT); }
__device__ __forceinline__ unsigned xb_xcc_id() { return (unsigned)__builtin_amdgcn_s_getreg((3 << 11) | 20) & 0xFu; }
#define XB_SPIN(cond, bar) do { unsigned _sp = 0; while (cond) { __builtin_amdgcn_s_sleep(1); \
    if ((++_sp & 255u) == 0u) { if (xb_ld(&(bar)[XB_TMO])) break; if (_sp > XB_SPIN_CAP) { atomicAdd(&(bar)[XB_TMO], 1u); break; } } } } while (0)

struct XcdBarrier {
    unsigned* bar; unsigned x;
    volatile LAS unsigned* st;
};

__device__ __forceinline__ XcdBarrier xcd_barrier_post(unsigned* bar, volatile LAS unsigned* st) {
    XcdBarrier b; b.bar = bar; b.x = xb_xcc_id(); b.st = st;
    if (threadIdx.x == 0) (void)xb_add(&bar[XB_XCNT(b.x)], 1u);
    return b;
}
__device__ __forceinline__ void xcd_barrier_complete(unsigned* bar, unsigned x, unsigned& nloc, unsigned& nx) {
    const unsigned G = gridDim.x * gridDim.y * gridDim.z;
    unsigned sum, cnt, mine, sp = 0u;
    for (;;) {
        sum = 0u; cnt = 0u; mine = 0u;
#pragma unroll
        for (unsigned j = 0; j < 16; ++j) { const unsigned c = xb_ld(&bar[XB_XCNT(j)]); sum += c; cnt += (c > 0u) ? 1u : 0u; mine = (j == x) ? c : mine; }
        if (sum == G) break;
        __builtin_amdgcn_s_sleep(1);
        if ((++sp & 255u) == 0u) { if (xb_ld(&bar[XB_TMO])) break; if (sp > XB_SPIN_CAP) { atomicAdd(&bar[XB_TMO], 1u); break; } }
    }
    nloc = mine > 0u ? mine : 1u; nx = cnt > 0u ? cnt : 1u;
}

__device__ __forceinline__ void xcd_barrier(const XcdBarrier& b) {
    asm volatile("s_waitcnt vmcnt(0)" ::: "memory");
    __syncthreads();
    if (threadIdx.x == 0) {
        unsigned* bar = b.bar;
        __builtin_amdgcn_s_waitcnt(0);
        unsigned nloc = b.st[0], nx = b.st[1];
        if (nloc == 0u) { xcd_barrier_complete(bar, b.x, nloc, nx); b.st[0] = nloc; b.st[1] = nx; }
        const unsigned old = xb_add(&bar[XB_XSUB(b.x)], 1u);
        const unsigned gen = old / nloc;
        if (old + 1u == (gen + 1u) * nloc) {
            __builtin_amdgcn_fence(__ATOMIC_RELEASE, "agent");
            asm volatile("s_waitcnt vmcnt(0)" ::: "memory");
            const unsigned og = xb_add(&bar[XB_TOP], 1u);
            const unsigned tg = og / nx;
            if (og + 1u == (tg + 1u) * nx) xb_add(&bar[XB_TOPGEN], 1u);
            else XB_SPIN(xb_ld(&bar[XB_TOPGEN]) == tg, bar);
            __builtin_amdgcn_fence(__ATOMIC_ACQUIRE, "agent");
            xb_add(&bar[XB_XGEN(b.x)], 1u);
            asm volatile("s_waitcnt vmcnt(0)" ::: "memory");
        } else {
            XB_SPIN(xb_ld(&bar[XB_XGEN(b.x)]) == gen, bar);
            __builtin_amdgcn_fence(__ATOMIC_ACQUIRE, "agent");
            asm volatile("s_waitcnt vmcnt(0)" ::: "memory");
        }
    }
    __syncthreads();
}

struct Args { const float* in[10]; float* out; unsigned char* ws; };

__device__ __forceinline__ void p0_transpose_item(const float* W, int K, int N, bf16* WT, int row_off, LAS float* scr, int item, int lane) {
    const int nblk = N / 32, kb = item / nblk, nb = item % nblk, k0 = 64 * kb, n0 = 32 * nb;
#pragma unroll 8
    for (int i = 0; i < 32; ++i) { const int kk = 2 * i + (lane >> 5); scr[kk * 33 + (lane & 31)] = W[(size_t)(k0 + kk) * N + n0 + (lane & 31)]; }
    LDS_WAIT(); asm volatile("" ::: "memory");
    const int c = lane & 7;
#pragma unroll
    for (int j = 0; j < 4; ++j) { const int n = (lane >> 3) + 8 * j; const LAS float* s = scr + (8 * c) * 33 + n;
        v4u o; o.x = pk2(s[0 * 33], s[1 * 33]); o.y = pk2(s[2 * 33], s[3 * 33]); o.z = pk2(s[4 * 33], s[5 * 33]); o.w = pk2(s[6 * 33], s[7 * 33]);
        *(v4u*)(WT + (size_t)(row_off + n0 + n) * K + k0 + 8 * c) = o; }
    LDS_WAIT(); asm volatile("" ::: "memory");
}

__device__ __forceinline__ void p0_prologue(const Args& a, LAS unsigned char* lds, int wave, int lane, int G) {
    unsigned char* ws = a.ws;
    LAS float* scr = (LAS float*)(lds + wave * 16384);
    const int gw = blockIdx.x * NWAVES + wave, NGW = G * NWAVES;
    constexpr int I_IN = (D / 64) * (NC / 32), I_PA = (512 / 64) * (D / 32), I_O = (D / 64) * (D / 32);
    constexpr int NITEMS = I_IN + 2 * I_PA + I_O;
    for (int it = gw; it < NITEMS; it += NGW) {
        int r = it;
        if (r < I_IN) { p0_transpose_item(a.in[3], D, NC, (bf16*)(ws + WS_WIN), 0, scr, r, lane); continue; } r -= I_IN;
        if (r < I_PA) { p0_transpose_item(a.in[6], 512, D, (bf16*)(ws + WS_WP), 0, scr, r, lane); continue; } r -= I_PA;
        if (r < I_PA) { p0_transpose_item(a.in[7], 512, D, (bf16*)(ws + WS_WP), 1024, scr, r, lane); continue; } r -= I_PA;
        p0_transpose_item(a.in[8], D, D, (bf16*)(ws + WS_WO), 0, scr, r, lane);
    }
    bf16* XN = (bf16*)(ws + WS_XN);
    const f32x4* gp = (const f32x4*)a.in[2] + lane;
    for (int m = gw; m < MP; m += NGW) {
        unsigned long long* o8 = (unsigned long long*)(XN + (size_t)m * D) + lane;
        if (m >= M + NMETA) {
#pragma unroll
            for (int j = 0; j < 4; ++j) o8[64 * j] = 0ull;
            continue;
        }
        const float* xrow = m < M ? a.in[0] + (size_t)m * D : a.in[1] + (size_t)(m - M) * D;
        const f32x4* xr = (const f32x4*)xrow + lane;
        f32x4 v[4]; float s = 0.f;
#pragma unroll
        for (int j = 0; j < 4; ++j) { v[j] = xr[64 * j]; s += (v[j].x * v[j].x + v[j].y * v[j].y) + (v[j].z * v[j].z + v[j].w * v[j].w); }
        const float rs = 1.f / sqrtf(wave_sum(s) * (1.f / D) + RMS_EPS);
#pragma unroll
        for (int j = 0; j < 4; ++j) { const f32x4 g = gp[64 * j]; const f32x4 y = v[j] * rs * g;
            o8[64 * j] = (unsigned long long)pk2(y.x, y.y) | ((unsigned long long)pk2(y.z, y.w) << 32); }
    }
    float* rope = (float*)(ws + WS_ROPE);
    const float inv_freq[8] = {1.0f, 0.19392274474868576f, 0.03760603093086393f, 0.007292664737217109f, 0.001414213562373095f, 0.0002742481756762073f, 5.318295896944988e-05f, 1.031338537721246e-05f};
    for (int pos = (int)threadIdx.x * G + (int)blockIdx.x; pos < LPOS; pos += G * 512) {
#pragma unroll
        for (int j = 0; j < 8; ++j) {
            const float ang = (float)pos * inv_freq[j];
            const double x = (double)ang, kq = __builtin_rint(x * 0.15915494309189535), r = x - kq * 6.283185307179586, r2 = r * r;
            double ts = 1.0, tc = 1.0, sn = 1.0, cs = 1.0;
#pragma unroll
            for (int n = 1; n <= 15; ++n) { tc *= r2 * (-1.0 / (double)((2 * n - 1) * (2 * n))); ts *= r2 * (-1.0 / (double)((2 * n) * (2 * n + 1))); cs += tc; sn += ts; }
            sn *= r;
            rope[pos * 16 + j] = (float)cs; rope[pos * 16 + 8 + j] = (float)sn;
        }
    }
}

__device__ __forceinline__ void naive_attn_phase(const Args& a, LAS unsigned char* lds, int wave, int lane, int G, int wlo, int whi) {
    const bf16* PROJ = (const bf16*)(a.ws + WS_PROJ);
    bf16* OAB = (bf16*)(a.ws + WS_XN);
    const float* sink = a.in[4]; const float* rpb = a.in[5];
    LAS float* pbuf = (LAS float*)(lds + wave * 2048);
    const int gw = blockIdx.x * NWAVES + wave, NGW = G * NWAVES;
    for (int it = gw + wlo * M * 8; it < whi * M * 8; it += NGW) {
        const int which = it >= M * 8 ? 1 : 0, r = it - which * M * 8, tok = r >> 3, h = r & 7, b = tok >> 13, t = tok & 8191;
        int qcol, kcol, vcol, zcol, nloc, t0 = 0, gr = 0, gc = 0, rs = 0, cs = 0;
        if (!which) { const int kvh = h >> 2; qcol = C_QA + h * 64; kcol = C_KA + kvh * 64; vcol = C_VA + kvh * 64; zcol = C_ZA + h * 64;
            t0 = t - 128 < 0 ? 0 : t - 128; const int t1 = t + 128 > SEQ - 1 ? SEQ - 1 : t + 128; nloc = t1 - t0 + 1; }
        else { qcol = C_QB + h * 64; kcol = C_KB + h * 64; vcol = C_VB + h * 64; zcol = C_ZB + h * 64; nloc = 128; gr = t >> 6; gc = t & 63;
            rs = gr - 4 < 0 ? 0 : (gr - 4 > 120 ? 120 : gr - 4); cs = gc - 8 < 0 ? 0 : (gc - 8 > 48 ? 48 : gc - 8); }
        const int nk = 16 + nloc;
        v4u qv[8];
        { const v4u* qp = (const v4u*)(PROJ + (size_t)tok * NC + qcol);
#pragma unroll
          for (int i = 0; i < 8; ++i) qv[i] = qp[i]; }
        float sv[5]; float mx = which ? -1e30f : sink[h] * LOG2E;
#pragma unroll
        for (int jj = 0; jj < 5; ++jj) {
            const int idx = lane + 64 * jj; float s = -1e30f;
            if (idx < nk) {
                int krow; float bias = 0.f;
                if (idx < 16) krow = M + idx;
                else if (!which) krow = b * SEQ + t0 + (idx - 16);
                else { const int j = idx - 16, kr = j >> 4, kc = j & 15; krow = b * SEQ + (rs + kr) * 64 + cs + kc;
                    bias = rpb[(h * 15 + (rs + kr - gr + 7)) * 31 + (cs + kc - gc + 15)] * LOG2E; }
                const v4u* kp = (const v4u*)(PROJ + (size_t)krow * NC + kcol);
                float acc = 0.f;
#pragma unroll
                for (int i = 0; i < 8; ++i) { const v4u kv = kp[i]; const v4u q = qv[i];
                    acc += pg8::bfl(q.x) * pg8::bfl(kv.x) + pg8::bfh(q.x) * pg8::bfh(kv.x) + pg8::bfl(q.y) * pg8::bfl(kv.y) + pg8::bfh(q.y) * pg8::bfh(kv.y)
                         + pg8::bfl(q.z) * pg8::bfl(kv.z) + pg8::bfh(q.z) * pg8::bfh(kv.z) + pg8::bfl(q.w) * pg8::bfl(kv.w) + pg8::bfh(q.w) * pg8::bfh(kv.w); }
                s = acc + bias;
            }
            sv[jj] = s; mx = fmaxf(mx, s);
        }
        mx = wave_max(mx);
        float l = 0.f;
#pragma unroll
        for (int jj = 0; jj < 5; ++jj) { const int idx = lane + 64 * jj; const float p = idx < nk ? exp2f(sv[jj] - mx) : 0.f; sv[jj] = p; l += p; }
        l = wave_sum(l); if (!which) l += exp2f(sink[h] * LOG2E - mx);
        const float inv = 1.f / l;
#pragma unroll
        for (int jj = 0; jj < 5; ++jj) { const int idx = lane + 64 * jj; if (idx < nk) pbuf[idx] = sv[jj] * inv; }
        LDS_WAIT(); asm volatile("" ::: "memory");
        float o = 0.f;
        for (int idx = 0; idx < nk; ++idx) {
            int krow;
            if (idx < 16) krow = M + idx;
            else if (!which) krow = b * SEQ + t0 + (idx - 16);
            else { const int j = idx - 16; krow = b * SEQ + (rs + (j >> 4)) * 64 + cs + (j & 15); }
            o += pbuf[idx] * bf2f(PROJ[(size_t)krow * NC + vcol + lane]);
        }
        const float z = bf2f(PROJ[(size_t)tok * NC + zcol + lane]);
        o *= z / (1.f + __expf(-z));
        OAB[(size_t)(which * M + tok) * 512 + h * 64 + lane] = (bf16)f2bf(o);
        LDS_WAIT(); asm volatile("" ::: "memory");
    }
}


typedef short s16x4 __attribute__((ext_vector_type(4)));
constexpr float NEG_BIG = -1e30f;
__device__ __forceinline__ int kvoff(int row, int c16) { return row * 128 + ((c16 ^ ((row >> 1) & 7)) << 4); }
__device__ __forceinline__ s16x4 vtr(LAS unsigned char* p) { return __builtin_amdgcn_ds_read_tr16_b64_v4i16((LAS s16x4*)p); }
__device__ __forceinline__ float ex2(float x) { return __builtin_amdgcn_exp2f(x); }
typedef float f32x2_t __attribute__((ext_vector_type(2))); typedef __bf16 bf16x2_t __attribute__((ext_vector_type(2)));
__device__ __forceinline__ unsigned cvtpk_s(float lo, float hi) { f32x2_t v = {lo, hi}; bf16x2_t b = __builtin_convertvector(v, bf16x2_t); return __builtin_bit_cast(unsigned, b); }
__device__ __forceinline__ bf16x8 pack_p(const f32x4& a, const f32x4& b) {
    v4u w; w.x = cvtpk_s(a[0], a[1]); w.y = cvtpk_s(a[2], a[3]); w.z = cvtpk_s(b[0], b[1]); w.w = cvtpk_s(b[2], b[3]);
    return __builtin_bit_cast(bf16x8, w);
}
__device__ __forceinline__ bf16x8 vfrag(LAS unsigned char* Vs, int row, int db, int p) {
    const int c16 = 2 * db + (p >> 1), h8 = (p & 1) * 8;
    const s16x4 lo = vtr(Vs + kvoff(row, c16) + h8), hi = vtr(Vs + kvoff(row + 16, c16) + h8);
    return (bf16x8){lo[0], lo[1], lo[2], lo[3], hi[0], hi[1], hi[2], hi[3]};
}
__device__ __forceinline__ float silu_(float z) { return z / (1.f + __expf(-z)); }

__device__ __forceinline__ void attn_a_phase(const Args& a, LAS unsigned char* lds, int tid, int wave, int lane, int G) {
    const bf16* PROJ = (const bf16*)(a.ws + WS_PROJ);
    bf16* OAB = (bf16*)(a.ws + WS_XN);
    constexpr int KROWS = 352;
    LAS unsigned char* Ks = lds; LAS unsigned char* Vs = lds + KROWS * 128;
    const int li = lane & 15, kg = lane >> 4, qp = li >> 2, pp = li & 3;
    __syncthreads();
    if (tid < 128) { const v4u z = {0u, 0u, 0u, 0u}; *(LAS v4u*)(Ks + 16 * 128 + tid * 16) = z; *(LAS v4u*)(Vs + 16 * 128 + tid * 16) = z; }
    for (int item = blockIdx.x; item < 512; item += G) {
        const int qt = item & 127, kvh = (item >> 7) & 1, b = item >> 8, tbase = qt * 64 - 128;
        __syncthreads();
        {
            v4u mv = {0u, 0u, 0u, 0u}; const int mw = tid >> 7, mp = tid & 127, mrow = mp >> 3, mc = mp & 7;
            if (tid < 256) mv = *(const v4u*)(PROJ + (size_t)(M + mrow) * NC + (mw ? C_VA : C_KA) + kvh * 64 + mc * 8);
            v4u kv[5], vv[5];
#pragma unroll
            for (int i = 0; i < 5; ++i) { const int p = tid + 512 * i, rr = p >> 3, c16 = p & 7, tok = tbase + rr;
                if (tok >= 0 && tok < SEQ) { const bf16* src = PROJ + (size_t)(b * SEQ + tok) * NC + kvh * 64 + c16 * 8; kv[i] = *(const v4u*)(src + C_KA); vv[i] = *(const v4u*)(src + C_VA); }
                else { kv[i] = (v4u){0u, 0u, 0u, 0u}; vv[i] = kv[i]; } }
            if (tid < 256) *(LAS v4u*)((mw ? Vs : Ks) + kvoff(mrow, mc)) = mv;
#pragma unroll
            for (int i = 0; i < 5; ++i) { const int p = tid + 512 * i, rr = p >> 3, c16 = p & 7; const int o = kvoff(32 + rr, c16);
                *(LAS v4u*)(Ks + o) = kv[i]; *(LAS v4u*)(Vs + o) = vv[i]; }
        }
        __syncthreads();
        const int hq = kvh * 4 + (wave & 3), qh = wave >> 2, tq0 = qt * 64 + qh * 32;
        bf16x8 Qf[2][2];
#pragma unroll
        for (int qb = 0; qb < 2; ++qb)
#pragma unroll
            for (int s = 0; s < 2; ++s) Qf[qb][s] = *(const bf16x8*)(PROJ + (size_t)(b * SEQ + tq0 + 16 * qb + li) * NC + C_QA + hq * 64 + 32 * s + 8 * kg);
        f32x4 O[4][2];
#pragma unroll
        for (int db = 0; db < 4; ++db) { O[db][0] = (f32x4){0.f, 0.f, 0.f, 0.f}; O[db][1] = O[db][0]; }
        const float sink2 = a.in[4][hq] * LOG2E;
        float mrow_[2] = {sink2, sink2}, lrow_[2] = {kg == 0 ? 1.f : 0.f, kg == 0 ? 1.f : 0.f};
        for (int ch = 0; ch < 10; ++ch) {
            int row0 = 0;
            if (ch > 0) { const int c = ch - 1 + qh; const int tok0 = tbase + 32 * c; if (tok0 < 0 || tok0 >= SEQ) continue; row0 = 32 + 32 * c; }
            bf16x8 Kf[2][2];
#pragma unroll
            for (int kb = 0; kb < 2; ++kb)
#pragma unroll
                for (int s = 0; s < 2; ++s) Kf[kb][s] = *(LAS const bf16x8*)(Ks + kvoff(row0 + 16 * kb + li, 4 * s + kg));
            f32x4 S[2][2];
#pragma unroll
            for (int kb = 0; kb < 2; ++kb)
#pragma unroll
                for (int qb = 0; qb < 2; ++qb) {
                    f32x4 z = {0.f, 0.f, 0.f, 0.f};
                    z = __builtin_amdgcn_mfma_f32_16x16x32_bf16(Kf[kb][0], Qf[qb][0], z, 0, 0, 0);
                    S[kb][qb] = __builtin_amdgcn_mfma_f32_16x16x32_bf16(Kf[kb][1], Qf[qb][1], z, 0, 0, 0);
                }
            if (ch == 0 || ch == 1 || ch == 9) {
#pragma unroll
                for (int kb = 0; kb < 2; ++kb)
#pragma unroll
                    for (int qb = 0; qb < 2; ++qb)
#pragma unroll
                        for (int j = 0; j < 4; ++j) { const int kk = 16 * kb + 4 * kg + j, qi = 16 * qb + li;
                            const bool ok = ch == 0 ? (kb == 0) : (ch == 1 ? kk >= qi : kk <= qi);
                            S[kb][qb][j] = ok ? S[kb][qb][j] : NEG_BIG; }
            }
            bf16x8 Pf[2];
#pragma unroll
            for (int qb = 0; qb < 2; ++qb) {
                float mx = fmaxf(fmaxf(fmaxf(S[0][qb][0], S[0][qb][1]), fmaxf(S[0][qb][2], S[0][qb][3])), fmaxf(fmaxf(S[1][qb][0], S[1][qb][1]), fmaxf(S[1][qb][2], S[1][qb][3])));
                mx = fmaxf(mx, __shfl_xor(mx, 16)); mx = fmaxf(mx, __shfl_xor(mx, 32));
                const float mnew = fmaxf(mrow_[qb], mx), alpha = ex2(mrow_[qb] - mnew); mrow_[qb] = mnew;
                float ls = 0.f;
#pragma unroll
                for (int kb = 0; kb < 2; ++kb)
#pragma unroll
                    for (int j = 0; j < 4; ++j) { const float p = ex2(S[kb][qb][j] - mnew); S[kb][qb][j] = p; ls += p; }
                lrow_[qb] = lrow_[qb] * alpha + ls;
#pragma unroll
                for (int db = 0; db < 4; ++db) O[db][qb] = O[db][qb] * alpha;
                Pf[qb] = pack_p(S[0][qb], S[1][qb]);
            }
#pragma unroll
            for (int db = 0; db < 4; ++db) {
                const bf16x8 Vf = vfrag(Vs, row0 + 4 * kg + qp, db, pp);
                O[db][0] = __builtin_amdgcn_mfma_f32_16x16x32_bf16(Vf, Pf[0], O[db][0], 0, 0, 0);
                O[db][1] = __builtin_amdgcn_mfma_f32_16x16x32_bf16(Vf, Pf[1], O[db][1], 0, 0, 0);
            }
        }
#pragma unroll
        for (int qb = 0; qb < 2; ++qb) {
            float l = lrow_[qb]; l += __shfl_xor(l, 16); l += __shfl_xor(l, 32);
            const float inv = 1.f / l;
            const size_t orow = (size_t)(b * SEQ + tq0 + 16 * qb + li);
#pragma unroll
            for (int db = 0; db < 4; ++db) { const int dcol = hq * 64 + 16 * db + 4 * kg;
                const v2u zz = *(const v2u*)(PROJ + orow * NC + C_ZA + dcol);
                const float o0 = O[db][qb][0] * inv * silu_(pg8::bfl(zz.x)), o1 = O[db][qb][1] * inv * silu_(pg8::bfh(zz.x)), o2 = O[db][qb][2] * inv * silu_(pg8::bfl(zz.y)), o3 = O[db][qb][3] * inv * silu_(pg8::bfh(zz.y));
                v2u w; w.x = pg8::cvt_pk_bf16(o0, o1); w.y = pg8::cvt_pk_bf16(o2, o3);
                *(v2u*)(OAB + orow * 512 + dcol) = w; }
        }
    }
}

__device__ __forceinline__ void attn_b_phase(const Args& a, LAS unsigned char* lds, int tid, int wave, int lane, int G) {
    const bf16* PROJ = (const bf16*)(a.ws + WS_PROJ);
    bf16* OAB = (bf16*)(a.ws + WS_XN);
    constexpr int KROWS = 608;
    LAS unsigned char* Ks = lds; LAS unsigned char* Vs = lds + KROWS * 128; LAS float* biasL = (LAS float*)(lds + 2 * KROWS * 128);
    const int li = lane & 15, kg = lane >> 4, qp = li >> 2, pp = li & 3;
    __syncthreads();
    if (tid < 128) { const v4u z = {0u, 0u, 0u, 0u}; *(LAS v4u*)(Ks + 16 * 128 + tid * 16) = z; *(LAS v4u*)(Vs + 16 * 128 + tid * 16) = z; }
    for (int item = blockIdx.x; item < 1024; item += G) {
        const int rp = item & 63, h = (item >> 6) & 7, b = item >> 9, r0 = 2 * rp;
        const int rs0 = r0 - 4 < 0 ? 0 : (r0 - 4 > 120 ? 120 : r0 - 4);
        __syncthreads();
        {
            if (tid < 480) { const int dr = tid >> 5, dc = tid & 31; biasL[tid] = dc < 31 ? a.in[5][(h * 15 + dr) * 31 + dc] * LOG2E : 0.f; }
            v4u mv = {0u, 0u, 0u, 0u}; const int mw = tid >> 7, mp = tid & 127, mrow = mp >> 3, mc = mp & 7;
            if (tid < 256) mv = *(const v4u*)(PROJ + (size_t)(M + mrow) * NC + (mw ? C_VB : C_KB) + h * 64 + mc * 8);
            if (tid < 256) *(LAS v4u*)((mw ? Vs : Ks) + kvoff(mrow, mc)) = mv;
#pragma unroll
            for (int half = 0; half < 3; ++half) {
                v4u kv[3], vv[3];
#pragma unroll
                for (int i = 0; i < 3; ++i) { const int p = tid + 512 * (3 * half + i), rr = p >> 3, c16 = p & 7, grow = rs0 + (rr >> 6);
                    if (grow < 128) { const bf16* src = PROJ + (size_t)(b * SEQ + grow * 64 + (rr & 63)) * NC + h * 64 + c16 * 8; kv[i] = *(const v4u*)(src + C_KB); vv[i] = *(const v4u*)(src + C_VB); }
                    else { kv[i] = (v4u){0u, 0u, 0u, 0u}; vv[i] = kv[i]; } }
#pragma unroll
                for (int i = 0; i < 3; ++i) { const int p = tid + 512 * (3 * half + i), rr = p >> 3, c16 = p & 7; const int o = kvoff(32 + rr, c16);
                    *(LAS v4u*)(Ks + o) = kv[i]; *(LAS v4u*)(Vs + o) = vv[i]; }
            }
        }
        __syncthreads();
        const int rsel = wave >> 2, qb = wave & 3, r = r0 + rsel;
        const int rs = r - 4 < 0 ? 0 : (r - 4 > 120 ? 120 : r - 4), roff = rs - rs0;
        const int cst = qb == 0 ? 0 : (qb == 1 ? 8 : (qb == 2 ? 24 : 32));
        const int c = 16 * qb + li, csq = c - 8 < 0 ? 0 : (c - 8 > 48 ? 48 : c - 8);
        const size_t qrow = (size_t)(b * SEQ + r * 64 + c);
        bf16x8 Qf[2];
#pragma unroll
        for (int s = 0; s < 2; ++s) Qf[s] = *(const bf16x8*)(PROJ + qrow * NC + C_QB + h * 64 + 32 * s + 8 * kg);
        f32x4 O[4];
#pragma unroll
        for (int db = 0; db < 4; ++db) O[db] = (f32x4){0.f, 0.f, 0.f, 0.f};
        float mrow_ = NEG_BIG, lrow_ = 0.f;
        for (int ch = 0; ch < 9; ++ch) {
            const int row0 = ch == 0 ? 0 : 32 + 64 * (roff + ch - 1) + cst;
            bf16x8 Kf[2][2];
#pragma unroll
            for (int kb = 0; kb < 2; ++kb)
#pragma unroll
                for (int s = 0; s < 2; ++s) Kf[kb][s] = *(LAS const bf16x8*)(Ks + kvoff(row0 + 16 * kb + li, 4 * s + kg));
            f32x4 S[2];
#pragma unroll
            for (int kb = 0; kb < 2; ++kb) {
                f32x4 z = {0.f, 0.f, 0.f, 0.f};
                z = __builtin_amdgcn_mfma_f32_16x16x32_bf16(Kf[kb][0], Qf[0], z, 0, 0, 0);
                S[kb] = __builtin_amdgcn_mfma_f32_16x16x32_bf16(Kf[kb][1], Qf[1], z, 0, 0, 0);
            }
            if (ch == 0) { S[1] = (f32x4){NEG_BIG, NEG_BIG, NEG_BIG, NEG_BIG}; }
            else {
                const int dr = rs + (ch - 1) - r + 7;
#pragma unroll
                for (int kb = 0; kb < 2; ++kb)
#pragma unroll
                    for (int j = 0; j < 4; ++j) { const int kc = cst + 16 * kb + 4 * kg + j; const bool ok = kc >= csq && kc <= csq + 15;
                        int dc = kc - c + 15; dc = dc < 0 ? 0 : (dc > 31 ? 31 : dc);
                        const float bv = biasL[dr * 32 + dc];
                        S[kb][j] = ok ? S[kb][j] + bv : NEG_BIG; }
            }
            float mx = fmaxf(fmaxf(fmaxf(S[0][0], S[0][1]), fmaxf(S[0][2], S[0][3])), fmaxf(fmaxf(S[1][0], S[1][1]), fmaxf(S[1][2], S[1][3])));
            mx = fmaxf(mx, __shfl_xor(mx, 16)); mx = fmaxf(mx, __shfl_xor(mx, 32));
            const float mnew = fmaxf(mrow_, mx), alpha = ex2(mrow_ - mnew); mrow_ = mnew;
            float ls = 0.f;
#pragma unroll
            for (int kb = 0; kb < 2; ++kb)
#pragma unroll
                for (int j = 0; j < 4; ++j) { const float p = ex2(S[kb][j] - mnew); S[kb][j] = p; ls += p; }
            lrow_ = lrow_ * alpha + ls;
            const bf16x8 Pf = pack_p(S[0], S[1]);
#pragma unroll
            for (int db = 0; db < 4; ++db) {
                const bf16x8 Vf = vfrag(Vs, row0 + 4 * kg + qp, db, pp);
                O[db] = __builtin_amdgcn_mfma_f32_16x16x32_bf16(Vf, Pf, O[db] * alpha, 0, 0, 0);
            }
        }
        float l = lrow_; l += __shfl_xor(l, 16); l += __shfl_xor(l, 32);
        const float inv = 1.f / l;
#pragma unroll
        for (int db = 0; db < 4; ++db) { const int dcol = h * 64 + 16 * db + 4 * kg;
            const v2u zz = *(const v2u*)(PROJ + qrow * NC + C_ZB + dcol);
            const float o0 = O[db][0] * inv * silu_(pg8::bfl(zz.x)), o1 = O[db][1] * inv * silu_(pg8::bfh(zz.x)), o2 = O[db][2] * inv * silu_(pg8::bfl(zz.y)), o3 = O[db][3] * inv * silu_(pg8::bfh(zz.y));
            v2u w; w.x = pg8::cvt_pk_bf16(o0, o1); w.y = pg8::cvt_pk_bf16(o2, o3);
            *(v2u*)(OAB + ((size_t)M + qrow) * 512 + dcol) = w; }
    }
}

__device__ __forceinline__ void final_norm_phase(const Args& a, int wave, int lane, int G) {
    const float* ssq = (const float*)(a.ws + WS_SSQ);
    const f32x4* gp = (const f32x4*)a.in[9] + lane;
    const int gw = blockIdx.x * NWAVES + wave, NGW = G * NWAVES;
    for (int m = gw; m < M; m += NGW) {
        float s = ssq[(size_t)m * 16 + (lane & 15)];
        s += __shfl_xor(s, 1); s += __shfl_xor(s, 2); s += __shfl_xor(s, 4); s += __shfl_xor(s, 8);
        const float rs = 1.f / sqrtf(s * (1.f / D) + RMS_EPS);
        f32x4* o = (f32x4*)(a.out + (size_t)m * D) + lane;
#pragma unroll
        for (int j = 0; j < 4; ++j) o[64 * j] = o[64 * j] * rs * gp[64 * j];
    }
}

__global__ void __launch_bounds__(NWAVES * 64, 2) fwd_kernel(Args a) {
    extern __shared__ __attribute__((aligned(16))) unsigned char lds_raw[];
    LAS unsigned char* lds = (LAS unsigned char*)lds_raw;
    cg::grid_group grid = cg::this_grid();
    const int tid = threadIdx.x, lane = tid & 63, wave = __builtin_amdgcn_readfirstlane(tid >> 6), G = gridDim.x;
    unsigned char* ws = a.ws;
    volatile LAS unsigned* bst = (volatile LAS unsigned*)(lds + LDS_BYTES - 64);
    if (tid < 16) bst[tid] = 0u;
    __syncthreads();
    const XcdBarrier xbar = xcd_barrier_post((unsigned*)ws, bst);
    if (ws == nullptr) grid.sync();
#define GRID_BAR() xcd_barrier(xbar)
    for (int rep = 0; rep < REP_P0; ++rep) p0_prologue(a, lds, wave, lane, G);
    GRID_BAR();
    for (int rep = 0; rep < REP_P1; ++rep)
    { pg8::Gemm g{(const pg8::bf16_t*)(ws + WS_XN), (const pg8::bf16_t*)(ws + WS_WIN), MP, NC, D};
      pg8::ProjOrder S; S.init(G, (int)blockIdx.x);
      pg8::EpiProj E{(pg8::bf16_t*)(ws + WS_PROJ), (const float*)(ws + WS_ROPE)};
      pg8::gemm_phase<pg8::EpiProj, pg8::ProjOrder, true, true>(lds, g, S, E); }
    GRID_BAR();
#ifndef NAIVE_A
    for (int rep = 0; rep < REP_A; ++rep) attn_a_phase(a, lds, tid, wave, lane, G);
#else
    naive_attn_phase(a, lds, wave, lane, G, 0, 1);
#endif
#ifndef NAIVE_B
    for (int rep = 0; rep < REP_B; ++rep) attn_b_phase(a, lds, tid, wave, lane, G);
#else
    __syncthreads();
    naive_attn_phase(a, lds, wave, lane, G, 1, 2);
#endif
    GRID_BAR();
    for (int rep = 0; rep < REP_P3; ++rep)
    { pg8::Gemm g{(const pg8::bf16_t*)(ws + WS_XN), (const pg8::bf16_t*)(ws + WS_WP), 2 * M, 2048, 512};
      pg8::MergeOrder S{G, (int)blockIdx.x};
      pg8::EpiMerge E{(const pg8::bf16_t*)(ws + WS_PROJ), (pg8::bf16_t*)(ws + WS_MG)};
      pg8::gemm_phase<pg8::EpiMerge, pg8::MergeOrder, true, true>(lds, g, S, E); }
    GRID_BAR();
    for (int rep = 0; rep < REP_P4; ++rep)
    { pg8::Gemm g{(const pg8::bf16_t*)(ws + WS_MG), (const pg8::bf16_t*)(ws + WS_WO), M, D, D};
      pg8::StaticOrder S; S.init(M, D, G, (int)blockIdx.x);
      pg8::EpiOut E{a.in[0], a.out, (float*)(ws + WS_SSQ)};
      pg8::gemm_phase<pg8::EpiOut, pg8::StaticOrder, false, true>(lds, g, S, E); }
    GRID_BAR();
    final_norm_phase(a, wave, lane, G);
}

extern "C" void kernel_launch(void* const* d_in, const int* in_sizes, int n_in, void* d_out, int out_size, void* d_ws, size_t ws_size, hipStream_t stream) {
    static int grid = 0;
    if (grid == 0) {
        if (n_in != 10 || in_sizes[0] != M * D || out_size != M * D || ws_size < 256 * MiB) { fprintf(stderr, "kernel_launch: unexpected shapes (n_in %d, in0 %d, out %d, ws %zu)\n", n_in, n_in > 0 ? in_sizes[0] : -1, out_size, ws_size); grid = -1; return; }
        int dev = 0, cus = 0, per_cu = 0;
        (void)hipGetDevice(&dev); (void)hipDeviceGetAttribute(&cus, hipDeviceAttributeMultiprocessorCount, dev);
        if (hipFuncSetAttribute((const void*)fwd_kernel, hipFuncAttributeMaxDynamicSharedMemorySize, LDS_BYTES) != hipSuccess) { fprintf(stderr, "kernel_launch: hipFuncSetAttribute failed\n"); grid = -1; return; }
        if (hipOccupancyMaxActiveBlocksPerMultiprocessor(&per_cu, (const void*)fwd_kernel, NWAVES * 64, LDS_BYTES) != hipSuccess || per_cu < 1) { fprintf(stderr, "kernel_launch: occupancy query says %d\n", per_cu); per_cu = 1; }
        (void)hipGetLastError();
        grid = cus;
    }
    if (grid < 0) return;
    if (hipMemsetAsync(d_ws, 0, 16384, stream) != hipSuccess) { fprintf(stderr, "kernel_launch: memset failed\n"); return; }
    Args a{};
    for (int i = 0; i < 10; ++i) a.in[i] = (const float*)d_in[i];
    a.out = (float*)d_out; a.ws = (unsigned char*)d_ws;
    void* args[] = {&a};
    hipError_t e = hipLaunchCooperativeKernel((const void*)fwd_kernel, dim3(grid), dim3(NWAVES * 64), args, LDS_BYTES, stream);
    if (e != hipSuccess) fprintf(stderr, "cooperative launch failed: %s (grid %d)\n", hipGetErrorString(e), grid);
}
```
